# Optimizing an MI355X kernel written in HIP

```python
import math
import jax, jax.numpy as jnp
from jax import lax
import numpy as np

D_MODEL = 2048
BATCH = 16
SEQ = 2048
DEPTH = 2

HEAD_DIM = 128
N_HEADS = D_MODEL // HEAD_DIM
D_MIX = N_HEADS * HEAD_DIM
FOX_HEADS = N_HEADS // 2
NSA_HEADS = N_HEADS - FOX_HEADS
NSA_KV_HEADS = 2
NSA_GROUP = NSA_HEADS // NSA_KV_HEADS
CMP_BLOCK = 32
CMP_STRIDE = 16
SEL_BLOCK = 64
SEL_TOPK = 16
WINDOW = 512
Q_BLOCK = 128
SEL_Q_CHUNK = 16
D_FF = 5632
CONV_WIDTH = 3
ROPE_THETA = 10000.0
FORGET_BIAS_INIT = 3.0
FORCE_BONUS = 1000.0
NEG_INF = -1e30
TINY = 1e-30
EPS = 1e-6
D_IN = 3 * FOX_HEADS * HEAD_DIM + FOX_HEADS + NSA_HEADS * HEAD_DIM + 6 * NSA_KV_HEADS * HEAD_DIM + 3 * NSA_HEADS

kernel_name = "hymba_fox_nsa_convffn_adaln"


def _rmsnorm(x, g):
    xf = x.astype(jnp.float32)
    y = xf * lax.rsqrt(jnp.mean(xf * xf, axis=-1, keepdims=True) + EPS)
    return (y * g.astype(jnp.float32)).astype(x.dtype)


def _rope_tables(s):
    inv = ROPE_THETA ** (-jnp.arange(0, HEAD_DIM, 2, dtype=jnp.float32) / HEAD_DIM)
    ang = jnp.arange(s, dtype=jnp.float32)[:, None] * inv[None, :]
    return jnp.cos(ang), jnp.sin(ang)


def _rope(t, cos, sin):
    half = HEAD_DIM // 2
    tf = t.astype(jnp.float32)
    t1, t2 = tf[..., :half], tf[..., half:]
    return jnp.concatenate([t1 * cos - t2 * sin, t1 * sin + t2 * cos], axis=-1).astype(t.dtype)


def _masked_softmax(s, mask):
    s = jnp.where(mask, s, NEG_INF)
    m = jnp.max(s, axis=-1, keepdims=True)
    p = jnp.where(mask, jnp.exp(s - m), 0.0)
    return p / jnp.maximum(jnp.sum(p, axis=-1, keepdims=True), TINY)


def _heads(t, n_heads):
    b, s, _ = t.shape
    return t.reshape(b, s, n_heads, HEAD_DIM).transpose(0, 2, 1, 3)


def _fox_attention(q, k, v, logf):
    b, h, s, d = q.shape
    cum = jnp.cumsum(logf.astype(jnp.float32), axis=-1)
    scale = 1.0 / math.sqrt(d)
    kpos = jnp.arange(s)

    def block(i):
        start = i * Q_BLOCK
        qb = lax.dynamic_slice_in_dim(q, start, Q_BLOCK, axis=2)
        cb = lax.dynamic_slice_in_dim(cum, start, Q_BLOCK, axis=2)
        sc = jnp.einsum('bhqd,bhkd->bhqk', qb, k, preferred_element_type=jnp.float32) * scale \
            + cb[..., :, None] - cum[..., None, :]
        qpos = start + jnp.arange(Q_BLOCK)
        p = _masked_softmax(sc, kpos[None, :] <= qpos[:, None])
        return jnp.einsum('bhqk,bhkd->bhqd', p.astype(v.dtype), v)

    out = lax.map(block, jnp.arange(s // Q_BLOCK))
    return out.transpose(1, 2, 0, 3, 4).reshape(b, h, s, d)


def _compress(t, pos, w1, w2):
    s = t.shape[2]
    n_cmp = (s - CMP_BLOCK) // CMP_STRIDE + 1
    idx = jnp.arange(n_cmp)[:, None] * CMP_STRIDE + jnp.arange(CMP_BLOCK)[None, :]
    blk = t[:, :, idx, :] + pos
    flat = blk.reshape(blk.shape[0], blk.shape[1], n_cmp, CMP_BLOCK * HEAD_DIM)
    return jax.nn.gelu(flat @ w1) @ w2


def _gather_blocks(blocks, idx):
    return jax.vmap(jax.vmap(lambda kb, ib: kb[ib]))(blocks, idx)


def _nsa_attention(q, k_c, v_c, k_s, v_s, k_w, v_w, gates,
                   cmp_pos_k, cmp_pos_v, w_cmp1_k, w_cmp2_k, w_cmp1_v, w_cmp2_v):
    b, _, s, d = q.shape
    scale = 1.0 / math.sqrt(d)
    qg = q.reshape(b, NSA_KV_HEADS, NSA_GROUP, s, d)
    qpos_all = jnp.arange(s)

    kc = _compress(k_c, cmp_pos_k, w_cmp1_k, w_cmp2_k)
    vc = _compress(v_c, cmp_pos_v, w_cmp1_v, w_cmp2_v)
    n_cmp = kc.shape[2]
    blk_end = jnp.arange(n_cmp) * CMP_STRIDE + CMP_BLOCK - 1
    sc = jnp.einsum('bhgqd,bhnd->bhgqn', qg, kc, preferred_element_type=jnp.float32) * scale
    p_cmp = _masked_softmax(sc, blk_end[None, :] <= qpos_all[:, None])
    o_cmp = jnp.einsum('bhgqn,bhnd->bhgqd', p_cmp.astype(vc.dtype), vc)

    n_sel = s // SEL_BLOCK
    p_pad = jnp.pad(p_cmp, ((0, 0), (0, 0), (0, 0), (0, 0), (0, s // CMP_STRIDE - n_cmp)))
    imp = p_pad.reshape(b, NSA_KV_HEADS, NSA_GROUP, s, n_sel, SEL_BLOCK // CMP_STRIDE).sum(axis=(2, 5))
    cur = (qpos_all // SEL_BLOCK)[:, None]
    blk = jnp.arange(n_sel)[None, :]
    forced = (blk == 0) | (blk == cur) | (blk == cur - 1)
    score = jnp.where(blk <= cur, imp + jnp.where(forced, FORCE_BONUS, 0.0), NEG_INF)
    k_eff = min(SEL_TOPK, n_sel)
    _, sel_idx = lax.top_k(score, k_eff)

    ks_blocks = k_s.reshape(b, NSA_KV_HEADS, n_sel, SEL_BLOCK, d)
    vs_blocks = v_s.reshape(b, NSA_KV_HEADS, n_sel, SEL_BLOCK, d)

    def sel_chunk(i):
        start = i * SEL_Q_CHUNK
        qc = lax.dynamic_slice_in_dim(qg, start, SEL_Q_CHUNK, axis=3)
        ic = lax.dynamic_slice_in_dim(sel_idx, start, SEL_Q_CHUNK, axis=2)
        kg = _gather_blocks(ks_blocks, ic)
        vg = _gather_blocks(vs_blocks, ic)
        ss = jnp.einsum('bhgqd,bhqnkd->bhgqnk', qc, kg, preferred_element_type=jnp.float32) * scale
        kpos = ic[..., None] * SEL_BLOCK + jnp.arange(SEL_BLOCK)
        qpos = start + jnp.arange(SEL_Q_CHUNK)
        mask = (kpos <= qpos[:, None, None]).reshape(b, NSA_KV_HEADS, 1, SEL_Q_CHUNK, k_eff * SEL_BLOCK)
        p = _masked_softmax(ss.reshape(b, NSA_KV_HEADS, NSA_GROUP, SEL_Q_CHUNK, k_eff * SEL_BLOCK), mask)
        p = p.reshape(b, NSA_KV_HEADS, NSA_GROUP, SEL_Q_CHUNK, k_eff, SEL_BLOCK)
        return jnp.einsum('bhgqnk,bhqnkd->bhgqd', p.astype(vg.dtype), vg)

    o_sel = lax.map(sel_chunk, jnp.arange(s // SEL_Q_CHUNK))
    o_sel = o_sel.transpose(1, 2, 3, 0, 4, 5).reshape(b, NSA_KV_HEADS, NSA_GROUP, s, d)

    kw_pad = jnp.pad(k_w, ((0, 0), (0, 0), (WINDOW, 0), (0, 0)))
    vw_pad = jnp.pad(v_w, ((0, 0), (0, 0), (WINDOW, 0), (0, 0)))

    def win_block(i):
        start = i * Q_BLOCK
        qb = lax.dynamic_slice_in_dim(qg, start, Q_BLOCK, axis=3)
        kb = lax.dynamic_slice_in_dim(kw_pad, start, WINDOW + Q_BLOCK, axis=2)
        vb = lax.dynamic_slice_in_dim(vw_pad, start, WINDOW + Q_BLOCK, axis=2)
        sw = jnp.einsum('bhgqd,bhkd->bhgqk', qb, kb, preferred_element_type=jnp.float32) * scale
        kpos = start - WINDOW + jnp.arange(WINDOW + Q_BLOCK)
        qpos = start + jnp.arange(Q_BLOCK)
        mask = (kpos[None, :] <= qpos[:, None]) & (kpos[None, :] > qpos[:, None] - WINDOW) & (kpos[None, :] >= 0)
        p = _masked_softmax(sw, mask)
        return jnp.einsum('bhgqk,bhkd->bhgqd', p.astype(vb.dtype), vb)

    o_win = lax.map(win_block, jnp.arange(s // Q_BLOCK))
    o_win = o_win.transpose(1, 2, 3, 0, 4, 5).reshape(b, NSA_KV_HEADS, NSA_GROUP, s, d)

    g = gates.reshape(b, NSA_KV_HEADS, NSA_GROUP, s, 3).astype(q.dtype)
    o = g[..., 0:1] * o_cmp + g[..., 1:2] * o_sel + g[..., 2:3] * o_win
    return o.reshape(b, NSA_HEADS, s, d)


def _hybrid_mixer(h, w_in, b_fgate, cmp_pos_k, cmp_pos_v, w_cmp1_k, w_cmp2_k, w_cmp1_v, w_cmp2_v,
                  w_out, cos, sin):
    b, s, _ = h.shape
    z = h @ w_in
    sizes = [FOX_HEADS * HEAD_DIM] * 3 + [FOX_HEADS] + [NSA_HEADS * HEAD_DIM] \
        + [NSA_KV_HEADS * HEAD_DIM] * 6 + [3 * NSA_HEADS]
    (fq, fk, fv, ff, nq, kc, vc, ks, vs, kw, vw, ng) = jnp.split(z, [int(o) for o in np.cumsum(sizes)[:-1]], axis=-1)

    logf = jax.nn.log_sigmoid((ff + b_fgate).astype(jnp.float32)).transpose(0, 2, 1)
    o_fox = _fox_attention(_heads(fq, FOX_HEADS), _heads(fk, FOX_HEADS), _heads(fv, FOX_HEADS), logf)

    rq = _rope(_heads(nq, NSA_HEADS), cos, sin)
    gates = jax.nn.sigmoid(ng.astype(jnp.float32)).reshape(b, s, NSA_HEADS, 3).transpose(0, 2, 1, 3)
    o_nsa = _nsa_attention(rq,
                           _rope(_heads(kc, NSA_KV_HEADS), cos, sin), _heads(vc, NSA_KV_HEADS),
                           _rope(_heads(ks, NSA_KV_HEADS), cos, sin), _heads(vs, NSA_KV_HEADS),
                           _rope(_heads(kw, NSA_KV_HEADS), cos, sin), _heads(vw, NSA_KV_HEADS),
                           gates, cmp_pos_k, cmp_pos_v, w_cmp1_k, w_cmp2_k, w_cmp1_v, w_cmp2_v)

    o = jnp.concatenate([o_fox, o_nsa], axis=1)
    return o.transpose(0, 2, 1, 3).reshape(b, s, D_MIX) @ w_out


def _conv_ffn(h, w_up, conv_w, conv_b, w_down):
    s = h.shape[1]
    u = h @ w_up
    up = jnp.pad(u, ((0, 0), (CONV_WIDTH - 1, 0), (0, 0)))
    y = conv_b
    for j in range(CONV_WIDTH):
        y = y + conv_w[j] * up[:, j:j + s]
    gate, val = jnp.split(y, 2, axis=-1)
    return (jax.nn.silu(gate) * val) @ w_down


def setup_inputs(seed: int = 0) -> dict:
    key = jax.random.key(seed)
    ks = jax.random.split(key, 20)
    f32 = jnp.float32
    nrm = lambda k, shape, sc: jax.random.normal(k, shape, f32) * sc
    L, D, HD = DEPTH, D_MODEL, HEAD_DIM
    return {
        "x": nrm(ks[0], (BATCH, SEQ, D), 1.0),
        "c": nrm(ks[1], (BATCH, D), 1.0),
        "attn_norm_g": 1.0 + nrm(ks[2], (L, D), 0.01),
        "ffn_norm_g": 1.0 + nrm(ks[3], (L, D), 0.01),
        "w_ada": nrm(ks[4], (L, D, 6 * D), 0.5 * D ** -0.5),
        "b_ada": nrm(ks[5], (L, 6 * D), 0.01),
        "w_in": nrm(ks[6], (L, D, D_IN), D ** -0.5),
        "b_fgate": FORGET_BIAS_INIT + nrm(ks[7], (L, FOX_HEADS), 0.5),
        "cmp_pos_k": nrm(ks[8], (L, CMP_BLOCK, HD), 0.02),
        "cmp_pos_v": nrm(ks[9], (L, CMP_BLOCK, HD), 0.02),
        "w_cmp1_k": nrm(ks[10], (L, CMP_BLOCK * HD, HD), (CMP_BLOCK * HD) ** -0.5),
        "w_cmp2_k": nrm(ks[11], (L, HD, HD), HD ** -0.5),
        "w_cmp1_v": nrm(ks[12], (L, CMP_BLOCK * HD, HD), (CMP_BLOCK * HD) ** -0.5),
        "w_cmp2_v": nrm(ks[13], (L, HD, HD), HD ** -0.5),
        "w_out": nrm(ks[14], (L, D_MIX, D), D_MIX ** -0.5),
        "w_up": nrm(ks[15], (L, D, 2 * D_FF), D ** -0.5),
        "conv_w": nrm(ks[16], (L, CONV_WIDTH, 2 * D_FF), CONV_WIDTH ** -0.5),
        "conv_b": nrm(ks[17], (L, 2 * D_FF), 0.01),
        "w_down": nrm(ks[18], (L, D_FF, D), D_FF ** -0.5),
        "final_norm_g": 1.0 + nrm(ks[19], (D,), 0.01),
    }


def reference(x, c, attn_norm_g, ffn_norm_g, w_ada, b_ada, w_in, b_fgate, cmp_pos_k, cmp_pos_v,
              w_cmp1_k, w_cmp2_k, w_cmp1_v, w_cmp2_v, w_out, w_up, conv_w, conv_b, w_down,
              final_norm_g):
    s = x.shape[1]
    cos, sin = _rope_tables(s)
    c_act = jax.nn.silu(c)
    for l in range(DEPTH):
        mod = c_act @ w_ada[l] + b_ada[l]
        sh_a, sc_a, g_a, sh_f, sc_f, g_f = [m[:, None, :] for m in jnp.split(mod, 6, axis=-1)]
        h = _rmsnorm(x, attn_norm_g[l]) * (1.0 + sc_a) + sh_a
        x = x + g_a * _hybrid_mixer(h, w_in[l], b_fgate[l], cmp_pos_k[l], cmp_pos_v[l],
                                    w_cmp1_k[l], w_cmp2_k[l], w_cmp1_v[l], w_cmp2_v[l], w_out[l], cos, sin)
        h = _rmsnorm(x, ffn_norm_g[l]) * (1.0 + sc_f) + sh_f
        x = x + g_f * _conv_ffn(h, w_up[l], conv_w[l], conv_b[l], w_down[l])
    return _rmsnorm(x, final_norm_g)
```

```cpp
#include <hip/hip_runtime.h>
#include <hip/hip_bf16.h>
#include <cstdio>
#include <cstdint>
#include <cmath>

#ifndef MK_ONE_LAUNCH
#define MK_ONE_LAUNCH 1
#endif

__device__ __forceinline__ int otid(int wave_id) { int l; asm volatile("v_mbcnt_lo_u32_b32 %0, -1, 0\n\tv_mbcnt_hi_u32_b32 %0, -1, %0" : "=v"(l)); return (wave_id << 6) | l; }
__device__ __forceinline__ float dpp_xor1(float v) { return __builtin_bit_cast(float, __builtin_amdgcn_mov_dpp(__builtin_bit_cast(int, v), 0xB1, 0xF, 0xF, true)); }
__device__ __forceinline__ float bperm(float v, int src_lane) { return __builtin_bit_cast(float, __builtin_amdgcn_ds_bpermute(src_lane << 2, __builtin_bit_cast(int, v))); }
__device__ __forceinline__ int obid() { int b = blockIdx.x; asm volatile("" : "+s"(b)); return b; }
__device__ __forceinline__ int ogrid() { int g = gridDim.x; asm volatile("" : "+s"(g)); return g; }

constexpr size_t EPI_WS_COS = 3u << 20, EPI_WS_SIN = (3u << 20) + 512 * 1024, EPI_WS_LOGF = 6u << 20, EPI_WS_G3 = 7u << 20, EPI_WS_Z = (size_t)352 << 20;
namespace pg8 {
#define PG8_LAS __attribute__((address_space(3)))
typedef unsigned short bf16_t;
typedef short bf16x8 __attribute__((ext_vector_type(8)));
typedef float f32x4 __attribute__((ext_vector_type(4)));
typedef unsigned u32x4 __attribute__((ext_vector_type(4)));
constexpr int BM = 256, BK = 64, HALF = 128, HTB = HALF * BK * 2  , STAGE_BYTES = 8 * HTB, NXCD = 8, WGM = 8;

__host__ __device__ __forceinline__ int lds_byte(int r, int c) { const int st = (r >> 4) * 2 + (c >> 5), rr = r & 15, cc = c & 31, ob = rr * 64 + cc * 2; return st * 1024 + (ob ^ (((ob >> 9) & 1) << 5)); }
__host__ __device__ __forceinline__ void stage_rc(int b, int& R, int& C) { const int st = b / 1024, sb = b % 1024, swz = sb ^ (((sb >> 9) & 1) << 5); R = (st >> 1) * 16 + swz / 64; C = (st & 1) * 32 + (swz % 64) / 2; }
__host__ __device__ __forceinline__ int perm32(int rho) { const int n = rho >> 4, i = rho & 15; return 8 * (i >> 2) + 4 * n + (i & 3); }

struct Unit { int pm, pn; };
struct Gemm { const bf16_t* A; const bf16_t* Bt; int M, N, K; };

struct StaticOrder {
    int nM, nN, nwg, G, c;
    __host__ __device__ void init(int M, int N, int G_, int c_) { nM = M / BM; nN = N / BM; nwg = nM * nN; G = G_; c = c_; }
    __host__ __device__ bool next(int i, Unit& u) const {
        const long L = (long)i * G + c; if (L >= nwg) return false;
        int wgid = (int)L; { const int q = nwg / NXCD, r = nwg % NXCD, xcd = wgid % NXCD, off = wgid / NXCD; wgid = (xcd < r ? xcd * (q + 1) : r * (q + 1) + (xcd - r) * q) + off; }
        const int nig = WGM * nN, gid = wgid / nig, fm = gid * WGM, gsz = (nM - fm) < WGM ? (nM - fm) : WGM;
        u.pm = fm + ((wgid % nig) % gsz); u.pn = (wgid % nig) / gsz; return true;
    }
    __device__ __forceinline__ void a_ready(const Unit&) const {}
    __device__ __forceinline__ void done(const Unit&) const {}
};

__device__ __forceinline__ unsigned cvt_pk_bf16(float lo, float hi) { unsigned r; asm volatile("v_cvt_pk_bf16_f32 %0, %1, %2" : "=v"(r) : "v"(lo), "v"(hi)); return r; }
typedef unsigned u32x2 __attribute__((ext_vector_type(2)));
typedef unsigned u32x4_t __attribute__((ext_vector_type(4)));
__device__ __forceinline__ float fast_sigmoid(float x) { return __builtin_amdgcn_rcpf(1.0f + __expf(-x)); }


__device__ __forceinline__ void row_rstd8(const float* ssq, const Unit& u, int wr, int fr, int fq, float (&rs)[2][4]) {
    const int lane = (fq << 4) | fr; typedef float f32x2_t __attribute__((ext_vector_type(2)));
    f32x2_t pr[2][4];
#pragma unroll
    for (int ai = 0; ai < 2; ++ai)
#pragma unroll
        for (int m = 0; m < 4; ++m) pr[ai][m] = *(const f32x2_t*)(ssq + (unsigned)((u.pm * BM + ai * HALF + wr * 64 + m * 16 + fr) * 8 + 2 * fq));
#pragma unroll
    for (int ai = 0; ai < 2; ++ai)
#pragma unroll
        for (int m = 0; m < 4; ++m) { float t = pr[ai][m].x + pr[ai][m].y; t += bperm(t, lane ^ 16); t += bperm(t, lane ^ 32); rs[ai][m] = __builtin_amdgcn_rsqf(t * (1.0f / 2048.0f) + 1e-6f); }
}

struct EpiInProj {
    static constexpr bool PERM = true, AFTER_DRAIN = false;
    __device__ __forceinline__ void prefetch(const Unit&, int, int) const {}
    unsigned char* ws; const float* ssq; const float* bias;
    __device__ __forceinline__ void operator()(const f32x4 (&acc)[2][2][4][2], const Unit& u, int wr, int wc, int fr0, int fq0) const {
        int ln_; asm volatile("v_mbcnt_lo_u32_b32 %0, -1, 0\n\tv_mbcnt_hi_u32_b32 %0, -1, %0" : "=v"(ln_)); const int fr = ln_ & 15, fq = ln_ >> 4; (void)fr0; (void)fq0;
        const int b = u.pm >> 3, t0 = (u.pm & 7) * 256;
        float rs[2][4]; row_rstd8(ssq, u, wr, fr, fq, rs);
        const float* bp = bias + (size_t)b * 5888 + u.pn * BM + wc * 32 + 8 * fq;
        bf16_t* Z = (bf16_t*)(ws + EPI_WS_Z); const float* cosT = (const float*)(ws + EPI_WS_COS); const float* sinT = (const float*)(ws + EPI_WS_SIN);
        {
            const int d1 = 16 * wc + 4 * fq;
            const int hs0 = 2 * u.pn;
            const bool rope = (hs0 >= 24 && hs0 < 34) || hs0 == 36 || hs0 == 40;
            f32x4 bz[2][2];
#pragma unroll
            for (int bj = 0; bj < 2; ++bj) { bz[bj][0] = *(const f32x4*)(bp + bj * HALF); bz[bj][1] = *(const f32x4*)(bp + bj * HALF + 4); }
            f32x4 cs[2][4], sn[2][4];
#pragma unroll
            for (int ai = 0; ai < 2; ++ai)
#pragma unroll
                for (int m = 0; m < 4; ++m) { const int t = t0 + 128 * ai + 64 * wr + 16 * m + fr; cs[ai][m] = (f32x4){1.f, 1.f, 1.f, 1.f}; sn[ai][m] = (f32x4){0.f, 0.f, 0.f, 0.f};
                    if (rope) { cs[ai][m] = *(const f32x4*)(cosT + t * 64 + d1); sn[ai][m] = *(const f32x4*)(sinT + t * 64 + d1); } }
#pragma unroll
            for (int ai = 0; ai < 2; ++ai) {
#pragma unroll
                for (int m = 0; m < 4; ++m) {
                    const int t = t0 + 128 * ai + 64 * wr + 16 * m + fr;
#pragma unroll
                    for (int bj = 0; bj < 2; ++bj) {
                        bf16_t* zp = Z + (unsigned)((((hs0 + bj) * 16 + b) * 2048 + t) * 128 + d1);
                        const f32x4 x1 = acc[ai][bj][m][0] * rs[ai][m] + bz[bj][0], x2 = acc[ai][bj][m][1] * rs[ai][m] + bz[bj][1];
                        const f32x4 y1 = x1 * cs[ai][m] - x2 * sn[ai][m], y2 = x1 * sn[ai][m] + x2 * cs[ai][m];
                        u32x2 w1, w2; w1.x = cvt_pk_bf16(y1[0], y1[1]); w1.y = cvt_pk_bf16(y1[2], y1[3]); w2.x = cvt_pk_bf16(y2[0], y2[1]); w2.y = cvt_pk_bf16(y2[2], y2[3]);
                        const auto r0 = __builtin_amdgcn_permlane16_swap(w1.x, w2.x, false, false); const auto r1 = __builtin_amdgcn_permlane16_swap(w1.y, w2.y, false, false);
                        u32x4_t wv; wv.x = r0[0]; wv.y = r1[0]; wv.z = r0[1]; wv.w = r1[1];
                        *(u32x4_t*)(zp + ((fq & 1) ? 60 : 0)) = wv;
                    }
                }
            }
        }
    }
};

template <bool NORM, bool XIN16> struct EpiRes {
    static constexpr bool PERM = true, AFTER_DRAIN = false;
    __device__ __forceinline__ void prefetch(const Unit&, int, int) const {}
    const void* xin; bf16_t* xout; const float* gate; bool st;
    bf16_t* An; const float* gn; const float* sc; float* ssq; PG8_LAS float* red;
    __device__ __forceinline__ void operator()(const f32x4 (&acc)[2][2][4][2], const Unit& u, int wr, int wc, int fr0, int fq0) const {
        int ln_; asm volatile("v_mbcnt_lo_u32_b32 %0, -1, 0\n\tv_mbcnt_hi_u32_b32 %0, -1, %0" : "=v"(ln_)); const int fr = ln_ & 15, fq = ln_ >> 4; (void)fr0; (void)fq0;
        const int b = u.pm >> 3; const int col0 = u.pn * BM + wc * 32 + 8 * fq; const int lane = (fq << 4) | fr;
        f32x4 g[2][2], gm[2][2];
#pragma unroll
        for (int bj = 0; bj < 2; ++bj)
#pragma unroll
            for (int n = 0; n < 2; ++n) { g[bj][n] = *(const f32x4*)(gate + (size_t)b * 12288 + col0 + bj * HALF + 4 * n);
                if constexpr (NORM) gm[bj][n] = *(const f32x4*)(gn + col0 + bj * HALF + 4 * n) * (*(const f32x4*)(sc + (size_t)b * 12288 + col0 + bj * HALF + 4 * n) + 1.0f); }
#pragma unroll
        for (int ai = 0; ai < 2; ++ai) {
            u32x4 xr[4][2]; f32x4 xf[4][2][2];
#pragma unroll
            for (int m = 0; m < 4; ++m) { const unsigned off = (unsigned)((u.pm * BM + ai * HALF + wr * 64 + m * 16 + fr) * 2048 + col0);
#pragma unroll
                for (int bj = 0; bj < 2; ++bj) {
                    if constexpr (XIN16) xr[m][bj] = *(const u32x4*)((const bf16_t*)xin + off + bj * HALF);
                    else { xf[m][bj][0] = *(const f32x4*)((const float*)xin + off + bj * HALF); xf[m][bj][1] = *(const f32x4*)((const float*)xin + off + bj * HALF + 4); } } }
#pragma unroll
            for (int m = 0; m < 4; ++m) { const int row = u.pm * BM + ai * HALF + wr * 64 + m * 16 + fr; const unsigned off = (unsigned)(row * 2048 + col0); float ss = 0.f;
#pragma unroll
                for (int bj = 0; bj < 2; ++bj) { f32x4 xn[2];
                    if constexpr (XIN16) { const u32x4 w = xr[m][bj];
                        xn[0] = (f32x4){__builtin_bit_cast(float, w.x << 16), __builtin_bit_cast(float, w.x & 0xffff0000u), __builtin_bit_cast(float, w.y << 16), __builtin_bit_cast(float, w.y & 0xffff0000u)};
                        xn[1] = (f32x4){__builtin_bit_cast(float, w.z << 16), __builtin_bit_cast(float, w.z & 0xffff0000u), __builtin_bit_cast(float, w.w << 16), __builtin_bit_cast(float, w.w & 0xffff0000u)}; }
                    else { xn[0] = xf[m][bj][0]; xn[1] = xf[m][bj][1]; }
#pragma unroll
                    for (int n = 0; n < 2; ++n) xn[n] = xn[n] + g[bj][n] * acc[ai][bj][m][n];
                    { u32x4 xb; xb.x = cvt_pk_bf16(xn[0][0], xn[0][1]); xb.y = cvt_pk_bf16(xn[0][2], xn[0][3]); xb.z = cvt_pk_bf16(xn[1][0], xn[1][1]); xb.w = cvt_pk_bf16(xn[1][2], xn[1][3]);
                      if (st) *(u32x4*)(xout + off + bj * HALF) = xb; else asm volatile("" :: "v"(xb)); }
                    if constexpr (NORM) { ss += ((xn[0][0] * xn[0][0] + xn[0][1] * xn[0][1]) + (xn[0][2] * xn[0][2] + xn[0][3] * xn[0][3])) + ((xn[1][0] * xn[1][0] + xn[1][1] * xn[1][1]) + (xn[1][2] * xn[1][2] + xn[1][3] * xn[1][3]));
                        const f32x4 y0 = xn[0] * gm[bj][0], y1 = xn[1] * gm[bj][1]; u32x4 w; w.x = cvt_pk_bf16(y0[0], y0[1]); w.y = cvt_pk_bf16(y0[2], y0[3]); w.z = cvt_pk_bf16(y1[0], y1[1]); w.w = cvt_pk_bf16(y1[2], y1[3]);
                        *(u32x4*)(An + off + bj * HALF) = w; } }
                if constexpr (NORM) { ss += bperm(ss, lane ^ 16); ss += bperm(ss, lane ^ 32); if (fq == 0) red[(ai * HALF + wr * 64 + m * 16 + fr) * 4 + wc] = ss; } }
        }
        if constexpr (NORM) {
            asm volatile("s_waitcnt lgkmcnt(0)" ::: "memory"); __builtin_amdgcn_s_barrier(); asm volatile("" ::: "memory");
            const int t = (wr * 4 + wc) * 64 + lane;
            if (t < 256) { const f32x4 q = *(const PG8_LAS f32x4*)(red + t * 4); ssq[(unsigned)((u.pm * BM + t) * 8 + u.pn)] = (q[0] + q[1]) + (q[2] + q[3]); }
            asm volatile("s_waitcnt lgkmcnt(0)" ::: "memory"); __builtin_amdgcn_s_barrier(); asm volatile("" ::: "memory");
        }
    }
};

struct EpiF32 {
    static constexpr bool PERM = true, AFTER_DRAIN = false;
    __device__ __forceinline__ void prefetch(const Unit&, int, int) const {}
    float* out; int ldc;
    __device__ __forceinline__ void operator()(const f32x4 (&acc)[2][2][4][2], const Unit& u, int wr, int wc, int fr0, int fq0) const {
        int ln_; asm volatile("v_mbcnt_lo_u32_b32 %0, -1, 0\n\tv_mbcnt_hi_u32_b32 %0, -1, %0" : "=v"(ln_)); const int fr = ln_ & 15, fq = ln_ >> 4; (void)fr0; (void)fq0;
        const int col0 = u.pn * BM + wc * 32 + 8 * fq;
#pragma unroll
        for (int ai = 0; ai < 2; ++ai)
#pragma unroll
            for (int m = 0; m < 4; ++m) { const size_t off = (size_t)(u.pm * BM + ai * HALF + wr * 64 + m * 16 + fr) * ldc + col0;
#pragma unroll
                for (int bj = 0; bj < 2; ++bj)
#pragma unroll
                    for (int n = 0; n < 2; ++n) *(f32x4*)(out + off + bj * HALF + 4 * n) = acc[ai][bj][m][n]; }
    }
};

struct EpiConvGate {
    static constexpr bool PERM = true, AFTER_DRAIN = false;
    bf16_t* ACT; bf16_t* SIDE; const float* cw; const float* cb; const float* ssq; const float* bias;
    PG8_LAS unsigned char* ex;
    __device__ __forceinline__ void prefetch(const Unit& u, int wid, int lane) const {
        __builtin_amdgcn_global_load_lds((const unsigned*)(ssq + (unsigned)((u.pm * BM + 32 * wid) * 8 + 4 * lane)), (PG8_LAS unsigned*)(ex + wid * 1024), 16, 0, 0);
        if (wid < 4) { const float* base = (wid < 3 ? cw + wid * 11264 : cb) + u.pn * 128 + (lane >> 5) * 5632 + (lane & 31) * 4;
            __builtin_amdgcn_global_load_lds((const unsigned*)base, (PG8_LAS unsigned*)(ex + 8192 + wid * 1024), 16, 0, 0); }
        else if (wid == 4) __builtin_amdgcn_global_load_lds((const unsigned*)(bias + (unsigned)((u.pm >> 3) * 11264 + u.pn * BM + 4 * lane)), (PG8_LAS unsigned*)(ex + 12288), 16, 0, 0);
    }
    __device__ __forceinline__ static f32x4 rotb(const f32x4 v, int src) { f32x4 r; r[0] = bperm(v[0], src); r[1] = bperm(v[1], src); r[2] = bperm(v[2], src); r[3] = bperm(v[3], src); return r; }
    __device__ __forceinline__ static void rot12(const f32x4 v, f32x4& r1, f32x4& r2) {
#pragma unroll
        for (int i = 0; i < 4; ++i) { float a, b2; const float x = v[i];
            asm volatile("s_nop 1\n\tv_mov_b32_dpp %0, %2 row_ror:1 row_mask:0xf bank_mask:0xf\n\tv_mov_b32_dpp %1, %2 row_ror:2 row_mask:0xf bank_mask:0xf" : "=&v"(a), "=&v"(b2) : "v"(x));
            r1[i] = a; r2[i] = b2; }
    }
    __device__ __forceinline__ void operator()(const f32x4 (&acc)[2][2][4][2], const Unit& u, int wr, int wc, int fr0, int fq0) const {
        int ln_; asm volatile("v_mbcnt_lo_u32_b32 %0, -1, 0\n\tv_mbcnt_hi_u32_b32 %0, -1, %0" : "=v"(ln_)); const int fr = ln_ & 15, fq = ln_ >> 4; (void)fr0; (void)fq0;
        const int lane = (fq << 4) | fr;
        float rs[2][4];
        { typedef float f32x2_t __attribute__((ext_vector_type(2)));
#pragma unroll
          for (int ai = 0; ai < 2; ++ai)
#pragma unroll
              for (int m = 0; m < 4; ++m) { const f32x2_t pr = *(const PG8_LAS f32x2_t*)(ex + ((ai * HALF + wr * 64 + m * 16 + fr) * 8 + 2 * fq) * 4);
                  float t = pr.x + pr.y; t += bperm(t, lane ^ 16); t += bperm(t, lane ^ 32); rs[ai][m] = __builtin_amdgcn_rsqf(t * (1.0f / 2048.0f) + 1e-6f); } }
        const PG8_LAS unsigned char* cwl = ex + 8192 + (wc * 32 + 4 * fq) * 4;
        const PG8_LAS unsigned char* bpl = ex + 12288 + (wc * 32 + 8 * fq) * 4;
        const int jj0 = u.pn * 128 + wc * 32 + 4 * fq;
        u32x2 wsv[2][4];
#pragma unroll
        for (int n = 0; n < 2; ++n) {
            const int jg = jj0 + 16 * n, jv = 5632 + jg;
            f32x4 w0[2], w1[2], w2[2], bc[2], bu[2];
#pragma unroll
            for (int hv = 0; hv < 2; ++hv) { const PG8_LAS unsigned char* q = cwl + hv * 512 + n * 64; w0[hv] = *(const PG8_LAS f32x4*)q; w1[hv] = *(const PG8_LAS f32x4*)(q + 1024); w2[hv] = *(const PG8_LAS f32x4*)(q + 2048); bc[hv] = *(const PG8_LAS f32x4*)(q + 3072);
                bu[hv] = *(const PG8_LAS f32x4*)(bpl + hv * 512 + n * 16); }
#pragma unroll
            for (int ai = 0; ai < 2; ++ai) {
                const int R0 = 128 * ai + 64 * wr; const int grp = (u.pm * BM + R0) >> 6;
                f32x4 pu[2];
#pragma unroll
                for (int hv = 0; hv < 2; ++hv) pu[hv] = (f32x4){0.f, 0.f, 0.f, 0.f};
#pragma unroll
                for (int m = 0; m < 4; ++m) {
                    f32x4 y[2];
#pragma unroll
                    for (int hv = 0; hv < 2; ++hv) {
                        const int jc = hv ? jv : jg;
                        const f32x4 uu = acc[ai][hv][m][n] * rs[ai][m] + bu[hv];
                        if ((m == 0 && fr < 2) || (m == 3 && fr >= 14)) { u32x2 sw; sw.x = cvt_pk_bf16(uu[0], uu[1]); sw.y = cvt_pk_bf16(uu[2], uu[3]);
                            *(u32x2*)(SIDE + (unsigned)((grp * 4 + (m == 0 ? fr : fr - 12)) * 11264 + jc)) = sw; }
                        const f32x4 wa = fr == 15 ? pu[hv] : uu, wb = fr >= 14 ? pu[hv] : uu;
                        pu[hv] = uu;
                        f32x4 yy = bc[hv] + w2[hv] * uu;
                        asm volatile("s_nop 1\n\t"
                                     "v_fmac_f32_dpp %0, %4, %12 row_ror:1 row_mask:0xf bank_mask:0xf\n\tv_fmac_f32_dpp %1, %5, %13 row_ror:1 row_mask:0xf bank_mask:0xf\n\t"
                                     "v_fmac_f32_dpp %2, %6, %14 row_ror:1 row_mask:0xf bank_mask:0xf\n\tv_fmac_f32_dpp %3, %7, %15 row_ror:1 row_mask:0xf bank_mask:0xf\n\t"
                                     "v_fmac_f32_dpp %0, %8, %16 row_ror:2 row_mask:0xf bank_mask:0xf\n\tv_fmac_f32_dpp %1, %9, %17 row_ror:2 row_mask:0xf bank_mask:0xf\n\t"
                                     "v_fmac_f32_dpp %2, %10, %18 row_ror:2 row_mask:0xf bank_mask:0xf\n\tv_fmac_f32_dpp %3, %11, %19 row_ror:2 row_mask:0xf bank_mask:0xf"
                                     : "+v"(yy[0]), "+v"(yy[1]), "+v"(yy[2]), "+v"(yy[3])
                                     : "v"(wa[0]), "v"(wa[1]), "v"(wa[2]), "v"(wa[3]), "v"(wb[0]), "v"(wb[1]), "v"(wb[2]), "v"(wb[3]),
                                       "v"(w1[hv][0]), "v"(w1[hv][1]), "v"(w1[hv][2]), "v"(w1[hv][3]), "v"(w0[hv][0]), "v"(w0[hv][1]), "v"(w0[hv][2]), "v"(w0[hv][3]));
                        y[hv] = yy;
                    }
                    f32x4 a;
#pragma unroll
                    for (int i = 0; i < 4; ++i) a[i] = y[0][i] * fast_sigmoid(y[0][i]) * y[1][i];
                    u32x2 w; w.x = cvt_pk_bf16(a[0], a[1]); w.y = cvt_pk_bf16(a[2], a[3]);
                    if (n == 0) wsv[ai][m] = w;
                    else {
                        const auto r0 = __builtin_amdgcn_permlane16_swap(wsv[ai][m].x, w.x, false, false); const auto r1 = __builtin_amdgcn_permlane16_swap(wsv[ai][m].y, w.y, false, false);
                        u32x4_t wv; wv.x = r0[0]; wv.y = r1[0]; wv.z = r0[1]; wv.w = r1[1];
                        *(u32x4_t*)(ACT + (unsigned)((u.pm * BM + R0 + 16 * m + fr) * 5632 + jj0 + ((fq & 1) ? 12 : 0))) = wv;
                    }
                }
            }
        }
    }
};

template <class Epi, class Sched, bool ALIGN_EPI = false, bool SP2 = false>
__device__ __forceinline__ void gemm_phase(PG8_LAS unsigned char* lds, const Gemm g, const Sched& S, const Epi& E, const int tid) {
    const int wid = __builtin_amdgcn_readfirstlane(tid >> 6), lane = tid & 63, wr = wid >> 2, wc = wid & 3, fr = lane & 15, fq = lane >> 4;
    const int K = g.K, nt = K / BK;
    unsigned voffA[2], voffB[2];
#pragma unroll
    for (int i = 0; i < 2; ++i) { int R, C; stage_rc(tid * 16 + i * 8192, R, C); const int Rb = Epi::PERM ? ((R & ~31) + perm32(R & 31)) : R;
        voffA[i] = (unsigned)(R * K + C) * 2u; voffB[i] = (unsigned)(Rb * K + C) * 2u; }
    const size_t kstep = (size_t)(BK * 2);
    const size_t hstep = (size_t)HALF * K * 2;
    const size_t tstep = 2 * hstep;
    const unsigned ldsw = (unsigned)wid * 1024u;
    const int aoff = lds_byte(wr * 64 + fr, fq * 8), boff = lds_byte(wc * 32 + fr, fq * 8);
#define PG8_SA(b, h) (((b) * 2 + (h)) * HTB)
#define PG8_SB(b, h) ((4 + (b) * 2 + (h)) * HTB)
#define PG8_STAGE(bufoff, gbase, voff) do { _Pragma("unroll") for (int _i = 0; _i < 2; ++_i) \
        __builtin_amdgcn_global_load_lds((const unsigned*)((const char*)(gbase) + (voff)[_i]), (PG8_LAS unsigned*)(lds + (bufoff) + ldsw + _i * 8192), 16, 0, 0); } while (0)
#define PG8_LDA(dst, b, h) do { _Pragma("unroll") for (int m = 0; m < 4; ++m) _Pragma("unroll") for (int k = 0; k < 2; ++k) dst[m][k] = *(const PG8_LAS bf16x8*)(lds + PG8_SA(b, h) + aoff + m * 2048 + k * 1024); } while (0)
#define PG8_LDB(dst, b, h) do { _Pragma("unroll") for (int n = 0; n < 2; ++n) _Pragma("unroll") for (int k = 0; k < 2; ++k) dst[n][k] = *(const PG8_LAS bf16x8*)(lds + PG8_SB(b, h) + boff + n * 2048 + k * 1024); } while (0)
#define PG8_MMA(ai, bj, At, Bt) do { __builtin_amdgcn_s_setprio(1); _Pragma("unroll") for (int m = 0; m < 4; ++m) _Pragma("unroll") for (int n = 0; n < 2; ++n) _Pragma("unroll") for (int k = 0; k < 2; ++k) \
        acc[ai][bj][m][n] = __builtin_amdgcn_mfma_f32_16x16x32_bf16(Bt[n][k], At[m][k], acc[ai][bj][m][n], 0, 0, 0); __builtin_amdgcn_s_setprio(0); } while (0)
#define PG8_WAIT_V(n) asm volatile("s_waitcnt vmcnt(" #n ")" ::: "memory")
#define PG8_WAIT_L(n) asm volatile("s_waitcnt lgkmcnt(" #n ")" ::: "memory")
#define PG8_BAR __builtin_amdgcn_s_barrier()
#define PG8_SCHED __builtin_amdgcn_sched_barrier(0)
    Unit cur, nxt; int ui = 0;
    if (!S.next(0, cur)) return;
    f32x4 acc[2][2][4][2];
#pragma unroll
    for (int a = 0; a < 2; ++a)
#pragma unroll
        for (int b = 0; b < 2; ++b)
#pragma unroll
            for (int m = 0; m < 4; ++m)
#pragma unroll
                for (int n = 0; n < 2; ++n) acc[a][b][m][n] = (f32x4){0.f, 0.f, 0.f, 0.f};
    bf16x8 At[4][2], B0[2][2], B1[2][2];
    const char* cA = (const char*)g.A + (size_t)cur.pm * tstep; const char* cB = (const char*)g.Bt + (size_t)cur.pn * tstep;
    S.a_ready(cur);
    if constexpr (SP2) {
        PG8_STAGE(PG8_SB(0, 0), cB, voffB); PG8_STAGE(PG8_SB(0, 1), cB + hstep, voffB); PG8_STAGE(PG8_SA(0, 0), cA, voffA); PG8_STAGE(PG8_SA(0, 1), cA + hstep, voffA);
        if (wr == 1) PG8_BAR;
        PG8_WAIT_V(2); PG8_BAR;
        PG8_STAGE(PG8_SB(1, 0), cB + kstep, voffB); PG8_STAGE(PG8_SA(1, 0), cA + kstep, voffA); PG8_STAGE(PG8_SB(1, 1), cB + hstep + kstep, voffB);
        PG8_WAIT_V(6); PG8_BAR;
    } else {
        PG8_STAGE(PG8_SB(0, 0), cB, voffB); PG8_STAGE(PG8_SA(0, 0), cA, voffA); PG8_STAGE(PG8_SB(0, 1), cB + hstep, voffB); PG8_STAGE(PG8_SA(0, 1), cA + hstep, voffA);
        if (wr == 1) PG8_BAR;
        PG8_WAIT_V(4); PG8_BAR;
        PG8_STAGE(PG8_SB(1, 0), cB + kstep, voffB); PG8_STAGE(PG8_SA(1, 0), cA + kstep, voffA); PG8_STAGE(PG8_SB(1, 1), cB + hstep + kstep, voffB);
        PG8_WAIT_V(6); PG8_BAR;
    }
    for (;;) {
        const bool has_next = S.next(ui + 1, nxt);
        const char* nA = has_next ? (const char*)g.A + (size_t)nxt.pm * tstep : cA; const char* nB = has_next ? (const char*)g.Bt + (size_t)nxt.pn * tstep : cB;
        for (int t = 0; t < nt; t += 2) {
            const bool last = (t == nt - 2);
            const char* a1 = cA + (size_t)(t + 1) * kstep;
            const char* a2 = last ? nA : cA + (size_t)(t + 2) * kstep; const char* b2 = last ? nB : cB + (size_t)(t + 2) * kstep;
            const char* a3 = a2 + kstep; const char* b3 = b2 + kstep;
            if (last && has_next) S.a_ready(nxt);
            if (last) E.prefetch(cur, wid, lane);
            if constexpr (SP2) {
            PG8_LDB(B0, 0, 0); PG8_LDB(B1, 0, 1); PG8_SCHED; PG8_LDA(At, 0, 0); PG8_STAGE(PG8_SA(1, 1), a1 + hstep, voffA);
            PG8_WAIT_V(8); PG8_WAIT_L(0); PG8_BAR; PG8_MMA(0, 0, At, B0); PG8_MMA(0, 1, At, B1); PG8_BAR; PG8_SCHED;
            PG8_LDA(At, 0, 1); PG8_STAGE(PG8_SB(0, 0), b2, voffB); PG8_STAGE(PG8_SB(0, 1), b2 + hstep, voffB); PG8_STAGE(PG8_SA(0, 0), a2, voffA);
            PG8_WAIT_V(8); PG8_WAIT_L(0); PG8_BAR; PG8_MMA(1, 0, At, B0); PG8_MMA(1, 1, At, B1); PG8_BAR; PG8_SCHED;
            PG8_LDB(B0, 1, 0); PG8_LDB(B1, 1, 1); PG8_SCHED; PG8_LDA(At, 1, 0); PG8_STAGE(PG8_SA(0, 1), a2 + hstep, voffA);
            PG8_WAIT_V(8); PG8_WAIT_L(0); PG8_BAR; PG8_MMA(0, 0, At, B0); PG8_MMA(0, 1, At, B1); PG8_BAR; PG8_SCHED;
            PG8_LDA(At, 1, 1); PG8_STAGE(PG8_SB(1, 0), b3, voffB); PG8_STAGE(PG8_SB(1, 1), b3 + hstep, voffB); PG8_STAGE(PG8_SA(1, 0), a3, voffA);
            PG8_WAIT_V(8); PG8_WAIT_L(0); PG8_BAR; PG8_MMA(1, 0, At, B0); PG8_MMA(1, 1, At, B1); PG8_BAR; PG8_SCHED;
            } else {
            PG8_LDB(B0, 0, 0); PG8_SCHED; PG8_LDA(At, 0, 0); PG8_STAGE(PG8_SA(1, 1), a1 + hstep, voffA);
            PG8_WAIT_L(8); PG8_BAR; PG8_WAIT_L(0); PG8_MMA(0, 0, At, B0); PG8_BAR; PG8_SCHED;
            PG8_LDB(B1, 0, 1); PG8_STAGE(PG8_SB(0, 0), b2, voffB);
            PG8_BAR; PG8_WAIT_L(0); PG8_MMA(0, 1, At, B1); PG8_BAR;
            PG8_LDA(At, 0, 1); PG8_STAGE(PG8_SA(0, 0), a2, voffA);
            PG8_BAR; PG8_WAIT_L(0); PG8_MMA(1, 0, At, B0); PG8_BAR; PG8_SCHED;
            PG8_STAGE(PG8_SB(0, 1), b2 + hstep, voffB);
            PG8_WAIT_V(6); PG8_BAR; PG8_MMA(1, 1, At, B1); PG8_BAR;
            PG8_LDB(B0, 1, 0); PG8_SCHED; PG8_LDA(At, 1, 0); PG8_STAGE(PG8_SA(0, 1), a2 + hstep, voffA);
            PG8_WAIT_L(8); PG8_BAR; PG8_WAIT_L(0); PG8_MMA(0, 0, At, B0); PG8_BAR; PG8_SCHED;
            PG8_LDB(B1, 1, 1); PG8_STAGE(PG8_SB(1, 0), b3, voffB);
            PG8_BAR; PG8_WAIT_L(0); PG8_MMA(0, 1, At, B1); PG8_BAR;
            PG8_LDA(At, 1, 1); PG8_STAGE(PG8_SA(1, 0), a3, voffA);
            PG8_BAR; PG8_WAIT_L(0); PG8_MMA(1, 0, At, B0); PG8_BAR; PG8_SCHED;
            PG8_STAGE(PG8_SB(1, 1), b3 + hstep, voffB);
            PG8_WAIT_V(6); PG8_BAR; PG8_MMA(1, 1, At, B1); PG8_BAR;
            }
        }
        if constexpr (ALIGN_EPI) { if (wr == 0) PG8_BAR; }
        if constexpr (!Epi::AFTER_DRAIN) { E(acc, cur, wr, wc, fr, fq); S.done(cur); }
        if (!has_next) break;
#pragma unroll
        for (int a = 0; a < 2; ++a)
#pragma unroll
            for (int b = 0; b < 2; ++b)
#pragma unroll
                for (int m = 0; m < 4; ++m)
#pragma unroll
                    for (int n = 0; n < 2; ++n) acc[a][b][m][n] = (f32x4){0.f, 0.f, 0.f, 0.f};
        cur = nxt; cA = nA; cB = nB; ++ui;
        if constexpr (ALIGN_EPI) { if (wr == 1) PG8_BAR; }
    }
    PG8_WAIT_V(0);
    if constexpr (!ALIGN_EPI) { if (wr == 0) PG8_BAR; }
    PG8_BAR;
    if constexpr (Epi::AFTER_DRAIN) { E.fused(acc, cur, wr, wc, fr, fq, lds, wid, lane); S.done(cur); }
#undef PG8_SA
#undef PG8_SB
#undef PG8_STAGE
#undef PG8_LDA
#undef PG8_LDB
#undef PG8_MMA
#undef PG8_WAIT_V
#undef PG8_WAIT_L
#undef PG8_BAR
#undef PG8_SCHED
}
}

namespace att {
constexpr int D = 128;
constexpr float SCALE = 0.08838834764831845f;
constexpr float THR = 8.f;
constexpr int NW = 8, QBLK = 32, KVBLK = 64, QB = NW * QBLK;
constexpr int SHM_V = KVBLK * D * 2, SHM_K = KVBLK * D * 2;
constexpr int LDS_WS = 2 * SHM_V + 2 * SHM_K, LDS_KB = LDS_WS + NW * 64 * 4, LDS_BYTES = LDS_KB + 2 * 64 * 4;
constexpr int LDO = 2048;

using bf16 = __hip_bfloat16;
typedef short bf16x8 __attribute__((ext_vector_type(8)));
typedef short s16x4 __attribute__((ext_vector_type(4)));
typedef float f32x16 __attribute__((ext_vector_type(16)));
typedef float f32x4 __attribute__((ext_vector_type(4)));
typedef unsigned u32x4 __attribute__((ext_vector_type(4)));

#define KSWZ(row, colB) ((row) * 256 + ((colB) ^ (((row) & 7) << 4)))
#define SBAR() __builtin_amdgcn_sched_barrier(0)
__device__ __forceinline__ int v_st(int k, int c) { const int kk = (k & ~0xC) | ((k & 4) << 1) | ((k & 8) >> 1); return ((kk >> 3) * 4 + (c >> 5)) * 512 + ((kk & 7) * 32 + (c & 31)) * 2; }
__device__ __forceinline__ int v_rd_base(int lane) { return ((lane & 3) << 3) | (((lane >> 2) & 3) << 6) | (((lane >> 4) & 1) << 5) | (((lane >> 5) & 1) << 8); }
constexpr int v_rd_off(int d0, int ks, int half) { return d0 * 512 + ks * 4096 + half * 2048; }
__device__ __forceinline__ int crow(int r, int hi) { return (r & 3) + 8 * (r >> 2) + 4 * hi; }
__device__ __forceinline__ unsigned cvtpk(float lo, float hi) {
    unsigned r; asm volatile("v_cvt_pk_bf16_f32 %0, %1, %2" : "=v"(r) : "v"(lo), "v"(hi)); return r;
}
__device__ __forceinline__ bf16x8 load8(const bf16* p) { return *reinterpret_cast<const bf16x8*>(p); }
__device__ __forceinline__ void mask_tile(f32x16& p0, f32x16& p1, int dq, unsigned W) {
    const float NEG = -__builtin_inff();
#pragma unroll
    for (int r = 0; r < 16; ++r) {
        const int c = (r & 3) + 8 * (r >> 2);
        if ((unsigned)(dq - c) >= W) p0[r] = NEG;
        if ((unsigned)(dq - c - 32) >= W) p1[r] = NEG;
    }
}
__device__ __forceinline__ void partialSM(f32x16& p0, f32x16& p1, float& m_reg, float& mn, float& alpha) {
    float pmax = p0[0]; for (int r = 1; r < 16; ++r) pmax = fmaxf(pmax, p0[r]); for (int r = 0; r < 16; ++r) pmax = fmaxf(pmax, p1[r]);
    { auto rr = __builtin_amdgcn_permlane32_swap(__float_as_uint(pmax), __float_as_uint(pmax), false, false);
      pmax = fmaxf(__uint_as_float(rr[0]), __uint_as_float(rr[1])); }
    constexpr float C2 = 1.4426950408889634f * SCALE;
    if (__builtin_expect(__all((pmax - m_reg) * SCALE <= THR), 1)) { mn = m_reg; alpha = 1.f; }
    else { mn = fmaxf(m_reg, pmax); alpha = __builtin_amdgcn_exp2f((m_reg - mn) * C2); m_reg = mn; }
    const float mnL = -mn * C2;
    for (int r = 0; r < 16; ++r) p0[r] = fmaf(p0[r], C2, mnL); for (int r = 0; r < 16; ++r) p1[r] = fmaf(p1[r], C2, mnL);
    for (int r = 0; r < 16; ++r) p0[r] = __builtin_amdgcn_exp2f(p0[r]);
}
#define ATT_PK4(P, B_, OUT) do { unsigned a0 = cvtpk(P[B_+0], P[B_+1]), a1 = cvtpk(P[B_+2], P[B_+3]);                          \
        unsigned b0 = cvtpk(P[B_+4], P[B_+5]), b1 = cvtpk(P[B_+6], P[B_+7]);                                             \
        auto r0 = __builtin_amdgcn_permlane32_swap(a0, b0, false, false); auto r1 = __builtin_amdgcn_permlane32_swap(a1, b1, false, false); \
        u32x4 w = {r0[0], r1[0], r0[1], r1[1]}; OUT = *reinterpret_cast<bf16x8*>(&w); } while (0)
__device__ __forceinline__ void finishSM(f32x16& p0, f32x16& p1, float alpha, float& l_reg, bf16x8& pa0, bf16x8& pa1, bf16x8& pa2, bf16x8& pa3) {
    for (int r = 0; r < 16; ++r) p1[r] = __builtin_amdgcn_exp2f(p1[r]);
    float ps = 0; for (int r = 0; r < 16; ++r) ps += p0[r]; for (int r = 0; r < 16; ++r) ps += p1[r];
    { auto rr = __builtin_amdgcn_permlane32_swap(__float_as_uint(ps), __float_as_uint(ps), false, false);
      ps = __uint_as_float(rr[0]) + __uint_as_float(rr[1]); }
    l_reg = l_reg * alpha + ps;
    ATT_PK4(p0, 0, pa0); ATT_PK4(p0, 8, pa1); ATT_PK4(p1, 0, pa2); ATT_PK4(p1, 8, pa3);
}
template <int KB, bool SK, int INIT = 0>
__device__ __forceinline__ void qkt(f32x16& p0, f32x16& p1, const char* K_lds, int r32, int hi, const bf16x8* qr, bool act, const float* kbias = nullptr, float iv = 0.f) {
    if (SK && !act) { const float NEG = -__builtin_inff();
#pragma unroll
        for (int r = 0; r < 16; ++r) { p0[r] = NEG; p1[r] = NEG; } return; }
    if constexpr (INIT == 1) { const float* kq_ = kbias + KB * 64 + 4 * hi;
#pragma unroll
        for (int a_ = 0; a_ < 4; ++a_) { const f32x4 b0_ = *(const f32x4*)(kq_ + 8 * a_), b1_ = *(const f32x4*)(kq_ + 32 + 8 * a_);
#pragma unroll
            for (int i_ = 0; i_ < 4; ++i_) { p0[4 * a_ + i_] = b0_[i_]; p1[4 * a_ + i_] = b1_[i_]; } } }
    else if constexpr (INIT == 2) {
#pragma unroll
        for (int r = 0; r < 16; ++r) { p0[r] = iv; p1[r] = iv; } }
    else { p0 = f32x16{}; p1 = f32x16{}; }
    const char* kb[4];
#pragma unroll
    for (int dd = 0; dd < 4; ++dd) kb[dd] = K_lds + KB * SHM_K + KSWZ(r32, (dd * 16 + hi * 8) * 2);
#pragma unroll
    for (int d0 = 0; d0 < 8; ++d0) { const char* a = kb[d0 & 3] + (d0 >> 2) * 128;
        bf16x8 b0 = *reinterpret_cast<const bf16x8*>(a);
        bf16x8 b1 = *reinterpret_cast<const bf16x8*>(a + 32 * 256);
        p0 = __builtin_amdgcn_mfma_f32_32x32x16_bf16(b0, qr[d0], p0, 0, 0, 0);
        p1 = __builtin_amdgcn_mfma_f32_32x32x16_bf16(b1, qr[d0], p1, 0, 0, 0); }
}
template <int VB, bool SK>
__device__ __forceinline__ void pv_tile(f32x16* o, int vb0, bf16x8 pa0, bf16x8 pa1, bf16x8 pa2, bf16x8 pa3, bool act) {
    if (SK && !act) return;
#define TRRD(dst, off) asm volatile("ds_read_b64_tr_b16 %0, %1 offset:%2" : "=&v"(dst) : "v"(vb0), "i"(off) : "memory")
#define PV_D0(d0) do { s16x4 l0, l1, l2, l3, h0, h1, h2, h3; constexpr int b_ = VB * SHM_V + v_rd_off(d0, 0, 0);     \
        TRRD(l0, b_); TRRD(h0, b_ + 2048); TRRD(l1, b_ + 4096); TRRD(h1, b_ + 6144); TRRD(l2, b_ + 8192); TRRD(h2, b_ + 10240); TRRD(l3, b_ + 12288); TRRD(h3, b_ + 14336); \
        asm volatile("s_waitcnt lgkmcnt(0)" ::: "memory"); SBAR();                 \
        o[d0] = __builtin_amdgcn_mfma_f32_32x32x16_bf16(pa0, (bf16x8){l0[0], l0[1], l0[2], l0[3], h0[0], h0[1], h0[2], h0[3]}, o[d0], 0, 0, 0);   \
        o[d0] = __builtin_amdgcn_mfma_f32_32x32x16_bf16(pa1, (bf16x8){l1[0], l1[1], l1[2], l1[3], h1[0], h1[1], h1[2], h1[3]}, o[d0], 0, 0, 0);   \
        o[d0] = __builtin_amdgcn_mfma_f32_32x32x16_bf16(pa2, (bf16x8){l2[0], l2[1], l2[2], l2[3], h2[0], h2[1], h2[2], h2[3]}, o[d0], 0, 0, 0);   \
        o[d0] = __builtin_amdgcn_mfma_f32_32x32x16_bf16(pa3, (bf16x8){l3[0], l3[1], l3[2], l3[3], h3[0], h3[1], h3[2], h3[3]}, o[d0], 0, 0, 0); } while (0)
    PV_D0(0); PV_D0(1); PV_D0(2); PV_D0(3);
#undef PV_D0
#undef TRRD
}

struct BlockRef { unsigned q, k, v, o, x, s; int P0; };
struct Bases { const bf16* Zb; bf16* Ob; const float* Xf; const unsigned* Sel; bool st; };
struct Seam {
    bf16x8 qr[8];
    bf16x8 st_v0, st_v1, st_k0, st_k1; float st_b;
};
__device__ __forceinline__ int swa_jlo(int P0, int W) { const int lowk = P0 - W + 1; return lowk > 0 ? lowk / KVBLK : 0; }
#define ROW(p, k0, rr) ((p) + (size_t)((k0) + (rr)) * D + sc)
#define VMW() asm volatile("s_waitcnt vmcnt(0)" ::: "memory")
#define VMWN(n) asm volatile("s_waitcnt vmcnt(%0)" :: "i"(n) : "memory")
#define SLOAD_H(Kp, Vp, Bp, k0) do { S.st_v0 = load8(ROW(Vp, k0, sr)); S.st_v1 = load8(ROW(Vp, k0, 32 + sr));              \
                         S.st_k0 = load8(ROW(Kp, k0, sr)); S.st_k1 = load8(ROW(Kp, k0, 32 + sr)); if constexpr (MODE == 0 && !(VAR & 1)) { if (wid == 0) S.st_b = (Bp)[(k0) + lane]; } } while (0)
#define SWRITE_HK(bf) do { *(bf16x8*)(K_lds + (bf) * SHM_K + kws) = S.st_k0; *(bf16x8*)(K_lds + (bf) * SHM_K + kws + 32 * 256) = S.st_k1; \
                         if constexpr (MODE == 0 && !(VAR & 1)) { if (wid == 0) kb_l[(bf) * 64 + lane] = S.st_b; } } while (0)
#define SWRITE_HV(bf) do { *(bf16x8*)(V_lds + (bf) * SHM_V + vst0) = S.st_v0; *(bf16x8*)(V_lds + (bf) * SHM_V + vst1) = S.st_v1; } while (0)
#define SWRITE_H(bf) do { SWRITE_HV(bf); SWRITE_HK(bf); } while (0)
template <int MODE, int VAR = 0>
__device__ __forceinline__ void att_prime(const Bases& BS, const BlockRef& cur, char* lds, Seam& S, const int tid) {
    constexpr int W = (MODE == 1) ? 512 : (1 << 30);
    const int wid = __builtin_amdgcn_readfirstlane(tid >> 6), lane = tid & 63, r32 = lane & 31, hi = lane >> 5;
    const int sr = tid >> 4, sc = (tid & 15) * 8, kws = KSWZ(sr, sc * 2); char* K_lds = lds + 2 * SHM_V; float* kb_l = (float*)(lds + LDS_KB);
    const int kb0 = swa_jlo(cur.P0, W) * KVBLK;
    for (int d0 = 0; d0 < 8; ++d0) S.qr[d0] = load8(BS.Zb + cur.q + (size_t)(wid * QBLK + r32) * D + d0 * 16 + hi * 8);
    SLOAD_H(BS.Zb + cur.k, BS.Zb + cur.v, BS.Xf + cur.x, kb0); VMW(); SWRITE_HK(0);
    __syncthreads();
}
template <int MODE, int VAR = 0>
__device__ __forceinline__ void att_block(const Bases& BS, const BlockRef& cur, const BlockRef& nxt, int skv, char* lds, Seam& S, const int tid) {
    constexpr int W = (MODE == 1) ? 512 : (1 << 30);
    constexpr bool SK = true;
    const int wid = __builtin_amdgcn_readfirstlane(tid >> 6), lane = tid & 63, r32 = lane & 31, hi = lane >> 5;
    const int j_lo = swa_jlo(cur.P0, W);
    int j_hi = (cur.P0 + QB - 1) / KVBLK + 1; if (j_hi > skv / KVBLK) j_hi = skv / KVBLK;
    const int NT = j_hi - j_lo;
    const int kbn = swa_jlo(nxt.P0, W) * KVBLK;
    const int qlo = cur.P0 + wid * QBLK, qm = qlo + r32 - 4 * hi;
    char* V_lds = lds; char* K_lds = lds + 2 * SHM_V;
    float* ws = (float*)(lds + LDS_WS) + wid * 64; float* li_l = ws, * al_l = ws + 32; float* kb_l = (float*)(lds + LDS_KB);
    float m_reg = -1e30f, l_reg = 0; f32x16 o[4] = {};
    const int sr = tid >> 4, sc = (tid & 15) * 8, vst0 = v_st(sr, sc), vst1 = v_st(32 + sr, sc), kws = KSWZ(sr, sc * 2);
    const int vb0 = (int)(uintptr_t)V_lds + v_rd_base(lane);
    const bf16* Kh = BS.Zb + cur.k; const bf16* Vh = BS.Zb + cur.v; const float* Bh = BS.Xf + cur.x;
    unsigned selw = 0xffffffffu; if constexpr (MODE == 2) selw = BS.Sel[cur.s + qlo + r32];
#define RESC(a) do { if (__any((a) < 1.f)) { if (hi == 0) al_l[r32] = (a); asm volatile("s_waitcnt lgkmcnt(0)" ::: "memory");              \
                     for (int d_ = 0; d_ < 4; ++d_) for (int r = 0; r < 16; ++r) o[d_][r] *= al_l[crow(r, hi)]; } } while (0)
#define KBASE(t) ((j_lo + (t)) * KVBLK)
#define ACT(t) (KBASE(t) <= qlo + QBLK - 1 && KBASE(t) + KVBLK - 1 >= qlo - W + 1)
#define SELIV(t) ((MODE == 2) ? ((((selw >> (j_lo + (t))) & 1u) != 0u) ? 0.f : -__builtin_inff()) : 0.f)
#define QKT(KB_, P0_, P1_, t) qkt<KB_, SK, ((MODE == 0 && !(VAR & 1)) ? 1 : (MODE == 2 ? 2 : 0))>(P0_, P1_, K_lds, r32, hi, S.qr, ACT(t), kb_l, SELIV(t))
#define MASKT(P0_, P1_, t, KBUF) do { const int kb_ = KBASE(t); if ((!SK || ACT(t)) && (kb_ + KVBLK - 1 > qlo || kb_ <= qlo + QBLK - 1 - W)) mask_tile(P0_, P1_, qm - kb_, (unsigned)W); } while (0)
    constexpr int NQL = 8;
#define SEAM_K0() do { VMWN(NQL); SWRITE_HK(0); SBAR(); } while (0)
    f32x16 pA0, pA1, pB0, pB1; float mnA, mnB, alA, alB; bf16x8 pa0, pa1, pa2, pa3;
    SWRITE_HV(0); SBAR();
    if (NT > 1) { SLOAD_H(Kh, Vh, Bh, KBASE(1)); }
    SBAR(); QKT(0, pA0, pA1, 0);
    MASKT(pA0, pA1, 0, 0); partialSM(pA0, pA1, m_reg, mnA, alA);
    if (NT > 1) { VMW(); SWRITE_H(1); }
    __syncthreads();
#define HALF_STEP(PX0, PX1, mnX, alX, PY0, PY1, alY, t, KB, VB, SB) do {                                                      \
        if ((t) + 1 < NT) { SLOAD_H(Kh, Vh, Bh, KBASE((t) + 1)); SBAR(); }     \
        SBAR(); QKT(KB, PX0, PX1, t);                                             \
        finishSM(PY0, PY1, alY, l_reg, pa0, pa1, pa2, pa3); SBAR();                                                           \
        pv_tile<VB, SK>(o, vb0, pa0, pa1, pa2, pa3, ACT((t) - 1)); MASKT(PX0, PX1, (t), KB); partialSM(PX0, PX1, m_reg, mnX, alX);                                        \
        __syncthreads();                                                                                                      \
        if ((t) + 1 < NT) { VMW(); SWRITE_H(SB); }                                                                          \
        RESC(alX); __syncthreads(); } while (0)
    for (int t = 1; t + 1 < NT; t += 2) {
        HALF_STEP(pB0, pB1, mnB, alB, pA0, pA1, alA, t, 1, 0, 0);
        HALF_STEP(pA0, pA1, mnA, alA, pB0, pB1, alB, t + 1, 0, 1, 1);
    }
    const bool even = (NT & 1) == 0;
    if (even) { SBAR(); QKT(1, pB0, pB1, NT - 1); SBAR(); }
    float gq = 1.f; if constexpr (MODE != 0) gq = BS.Xf[cur.x + qlo + r32];
    SLOAD_H(BS.Zb + nxt.k, BS.Zb + nxt.v, BS.Xf + nxt.x, kbn); SBAR();
#pragma unroll
    for (int d0 = 0; d0 < 8; ++d0) S.qr[d0] = load8(BS.Zb + nxt.q + (size_t)(wid * QBLK + r32) * D + d0 * 16 + hi * 8);
    SBAR();
    finishSM(pA0, pA1, alA, l_reg, pa0, pa1, pa2, pa3); SBAR();
    pv_tile<0, SK>(o, vb0, pa0, pa1, pa2, pa3, ACT(even ? NT - 2 : NT - 1));
    if (even) { MASKT(pB0, pB1, NT - 1, 1); partialSM(pB0, pB1, m_reg, mnB, alB); __syncthreads(); RESC(alB);
        finishSM(pB0, pB1, alB, l_reg, pa0, pa1, pa2, pa3); SBAR(); pv_tile<1, SK>(o, vb0, pa0, pa1, pa2, pa3, ACT(NT - 1)); }
    SBAR(); SEAM_K0();
    if (hi == 0) li_l[r32] = gq / l_reg; asm volatile("s_waitcnt lgkmcnt(0)" ::: "memory");
    float rli[16];
#pragma unroll
    for (int r = 0; r < 16; ++r) rli[r] = li_l[crow(r, hi)];
    int hi_e = hi, r32_e = r32; asm volatile("" : "+v"(hi_e), "+v"(r32_e));
    {
        char* stg = lds + 73728 + wid * 8704;
        char* wp = stg + (4 * hi_e) * 272 + r32_e * 2;
        const int le = hi_e * 32 + r32_e, rrow = le >> 4, cb = (le & 15) * 16;
        bf16* Og = BS.Ob + cur.o + (size_t)(wid * QBLK + rrow) * LDO + (cb >> 1);
        u32x4 sv[8], old[8];
        if constexpr (MODE == 2) {
#pragma unroll
            for (int j = 0; j < 8; ++j) old[j] = *(const u32x4*)(Og + (size_t)(4 * j) * LDO);
        }
#pragma unroll
        for (int d0 = 0; d0 < 4; ++d0) {
            float v16[16], n16[16];
#pragma unroll
            for (int r = 0; r < 16; ++r) { v16[r] = o[d0][r] * rli[r]; n16[r] = dpp_xor1(v16[r]); }
            if ((r32 & 1) == 0) {
#pragma unroll
                for (int r = 0; r < 16; ++r) *(unsigned*)(wp + crow(r, 0) * 272 + d0 * 64) = cvtpk(v16[r], n16[r]);
            }
        }
        asm volatile("s_waitcnt lgkmcnt(0)" ::: "memory");
        const char* rp = stg + rrow * 272 + cb;
#pragma unroll
        for (int j = 0; j < 8; ++j) sv[j] = *(const u32x4*)(rp + (4 * j) * 272);
#pragma unroll
        for (int j = 0; j < 8; ++j) {
            u32x4 w = sv[j];
            if constexpr (MODE == 2) {
#pragma unroll
                for (int e = 0; e < 4; ++e) w[e] = cvtpk(__uint_as_float(sv[j][e] << 16) + __uint_as_float(old[j][e] << 16), __uint_as_float(sv[j][e] & 0xffff0000u) + __uint_as_float(old[j][e] & 0xffff0000u));
            }
            if (BS.st) *(u32x4*)(Og + (size_t)(4 * j) * LDO) = w; else asm volatile("" :: "v"(w));
        }
    }
    __syncthreads();
#undef RESC
#undef KBASE
#undef ACT
#undef SELIV
#undef QKT
#undef MASKT
#undef SEAM_K0
#undef HALF_STEP
}
#undef ROW
#undef VMW
#undef VMWN
#undef SLOAD_H
#undef SWRITE_HK
#undef SWRITE_HV
#undef SWRITE_H
}

using att::crow; using att::cvtpk; typedef att::u32x4 u32x4;

constexpr int NWAVES = 8, NTHREADS = 512;
constexpr int BATCH = 16, SEQ = 2048, DM = 2048, MROWS = BATCH * SEQ, DFF = 5632, NUP = 2 * DFF, DIN = 5664, NINP = 5888, DEPTH = 2;
constexpr float RMS_EPS = 1e-6f;
constexpr size_t MiB = 1u << 20;
constexpr size_t WS_CTL = 0, CTL_ZERO_BYTES = 64 * 1024;
constexpr size_t WS_MOD = 1 * MiB;
constexpr size_t WS_COS = 3 * MiB, WS_SIN = 3 * MiB + 512 * 1024;
constexpr size_t WS_POSB = 4 * MiB;
constexpr size_t WS_KBIAS = 5 * MiB;
constexpr size_t WS_LOGF = 6 * MiB;
constexpr size_t WS_G3 = 7 * MiB;
constexpr size_t WS_SELM = 10 * MiB;
constexpr size_t WS_KCMP = 11 * MiB, WS_VCMPT = 12 * MiB;
constexpr size_t WS_T1 = 13 * MiB;
constexpr size_t WS_W = 24 * MiB;
constexpr size_t W_IN = 0, W_OUT = 23 * MiB, W_UP = 31 * MiB, W_DOWN = 75 * MiB, W_C1 = 97 * MiB, W_LAYER = 99 * MiB;
constexpr size_t WS_H = 224 * MiB;
constexpr size_t WS_Z = 352 * MiB;
constexpr size_t WS_O = 704 * MiB;
constexpr size_t WS_ACT = WS_Z;
constexpr size_t WS_SIDE = 832 * MiB;
constexpr size_t WS_SSQ = 876 * MiB;
constexpr size_t SSQ_BYTES = (size_t)32768 * 8 * 4;
constexpr size_t WS_BIAS = 21 * MiB;
constexpr size_t BIAS_UP_OFF = (size_t)2 * 16 * 5888 * 4;
constexpr size_t WS_XB = 880 * MiB;
constexpr size_t WS_END = 1008 * MiB;
static_assert(WS_W + 2 * W_LAYER <= WS_H && WS_H + 128 * MiB <= WS_Z && WS_Z + 352 * MiB <= WS_O && WS_O + 128 * MiB <= WS_SIDE && WS_SIDE + 44 * MiB <= WS_SSQ && WS_SSQ + 4 * SSQ_BYTES <= WS_XB && WS_XB + 128 * MiB <= WS_END && WS_BIAS + BIAS_UP_OFF + (size_t)2 * 16 * 11264 * 4 <= WS_W && WS_T1 + 8 * MiB <= WS_BIAS, "ws map");
constexpr int CW_BAR = 1024;
constexpr int SCR_BYTES = 148 * 1024;
constexpr int MISC_OFF = SCR_BYTES;
constexpr int LDS_BYTES = 159744;

#define GAS __attribute__((address_space(1)))
#define LAS __attribute__((address_space(3)))
typedef unsigned short bf16;
typedef unsigned v4u __attribute__((ext_vector_type(4)));
typedef unsigned v2u __attribute__((ext_vector_type(2)));
typedef float f32x4 __attribute__((ext_vector_type(4)));
typedef float f32x2 __attribute__((ext_vector_type(2)));
typedef float f32x16 __attribute__((ext_vector_type(16)));
typedef short bf16x8 __attribute__((ext_vector_type(8)));
#define LDS_WAIT() asm volatile("s_waitcnt lgkmcnt(0)" ::: "memory")
#define VM_WAIT() asm volatile("s_waitcnt vmcnt(0)" ::: "memory")
__device__ __forceinline__ unsigned f2bf(float f) { unsigned u = __builtin_bit_cast(unsigned, f); return (u + 0x7fffu + ((u >> 16) & 1u)) >> 16; }
__device__ __forceinline__ unsigned pk2(float lo, float hi) { return f2bf(lo) | (f2bf(hi) << 16); }
__device__ __forceinline__ float bf2f(unsigned short h) { return __builtin_bit_cast(float, (unsigned)h << 16); }

static_assert(EPI_WS_COS == WS_COS && EPI_WS_SIN == WS_SIN && EPI_WS_LOGF == WS_LOGF && EPI_WS_G3 == WS_G3 && EPI_WS_Z == WS_Z, "epilogue offsets");
#define XB_TMO      128
#define XB_XCNT(j)  (256  + 64 * (j))
#define XB_XSUB(j)  (1280 + 64 * (j))
#define XB_XGEN(j)  (2304 + 64 * (j))
#define XB_TOP      3328
#define XB_TOPGEN   3392
#define XCD_BAR_WORDS 3456
#define XB_SPIN_CAP (1u << 18)

__device__ __forceinline__ unsigned xb_ld(unsigned* p)              { return __hip_atomic_load(p, __ATOMIC_RELAXED, __HIP_MEMORY_SCOPE_AGENT); }
__device__ __forceinline__ unsigned xb_add(unsigned* p, unsigned v) { return __hip_atomic_fetch_add(p, v, __ATOMIC_RELAXED, __HIP_MEMORY_SCOPE_AGENT); }
__device__ __forceinline__ unsigned xb_xcc_id() { return (unsigned)__builtin_amdgcn_s_getreg((3 << 11) | 20) & 0xFu; }
#define XB_SPIN(cond, bar) do { unsigned _sp = 0; while (cond) { __builtin_amdgcn_s_sleep(1); \
    if ((++_sp & 255u) == 0u) { if (xb_ld(&(bar)[XB_TMO])) break; if (_sp > XB_SPIN_CAP) { atomicAdd(&(bar)[XB_TMO], 1u); break; } } } } while (0)

struct XcdBarrier {
    unsigned* bar; unsigned x;
    volatile LAS unsigned* st;
};

__device__ __forceinline__ XcdBarrier xcd_barrier_post(unsigned* bar, volatile LAS unsigned* st) {
    XcdBarrier b; b.bar = bar; b.x = xb_xcc_id(); b.st = st;
    if (threadIdx.x == 0) (void)xb_add(&bar[XB_XCNT(b.x)], 1u);
    return b;
}
__device__ __forceinline__ void xcd_barrier_complete(unsigned* bar, unsigned x, unsigned& nloc, unsigned& nx) {
    const unsigned G = gridDim.x * gridDim.y * gridDim.z;
    unsigned sum, cnt, mine, sp = 0u;
    for (;;) {
        sum = 0u; cnt = 0u; mine = 0u;
        unsigned xo = x; asm volatile("" : "+s"(xo));
#pragma unroll
        for (unsigned j = 0; j < 16; ++j) { const unsigned c = xb_ld(&bar[XB_XCNT(j)]); sum += c; cnt += (c > 0u) ? 1u : 0u; mine = (j == xo) ? c : mine; }
        if (sum == G) break;
        __builtin_amdgcn_s_sleep(1);
        if ((++sp & 255u) == 0u) { if (xb_ld(&bar[XB_TMO])) break; if (sp > XB_SPIN_CAP) { atomicAdd(&bar[XB_TMO], 1u); break; } }
    }
    nloc = mine > 0u ? mine : 1u; nx = cnt > 0u ? cnt : 1u;
}

__device__ __forceinline__ void xcd_barrier(const XcdBarrier& b, const bool thread0  ) {
    asm volatile("s_waitcnt vmcnt(0)" ::: "memory");
    __syncthreads();
    if (thread0) {
        unsigned* bar = b.bar;
        __builtin_amdgcn_s_waitcnt(0);
        unsigned nloc = b.st[0], nx = b.st[1];
        if (nloc == 0u) { xcd_barrier_complete(bar, b.x, nloc, nx); b.st[0] = nloc; b.st[1] = nx; }
        const unsigned old = xb_add(&bar[XB_XSUB(b.x)], 1u);
        const unsigned gen = old / nloc;
        if (old + 1u == (gen + 1u) * nloc) {
            __builtin_amdgcn_fence(__ATOMIC_RELEASE, "agent");
            asm volatile("s_waitcnt vmcnt(0)" ::: "memory");
            const unsigned og = xb_add(&bar[XB_TOP], 1u);
            const unsigned tg = og / nx;
            if (og + 1u == (tg + 1u) * nx) xb_add(&bar[XB_TOPGEN], 1u);
            else XB_SPIN(xb_ld(&bar[XB_TOPGEN]) == tg, bar);
            __builtin_amdgcn_fence(__ATOMIC_ACQUIRE, "agent");
            xb_add(&bar[XB_XGEN(b.x)], 1u);
            asm volatile("s_waitcnt vmcnt(0)" ::: "memory");
        } else {
            XB_SPIN(xb_ld(&bar[XB_XGEN(b.x)]) == gen, bar);
            __builtin_amdgcn_fence(__ATOMIC_ACQUIRE, "agent");
            asm volatile("s_waitcnt vmcnt(0)" ::: "memory");
        }
    }
    __syncthreads();
}


extern __shared__ __attribute__((aligned(16))) unsigned char g_lds[];
#define LDSL ((LAS unsigned char*)g_lds)
struct Frame { int vcu, G, bx, wave_id; };
__device__ __forceinline__ Frame mkframe(int wave_id) { Frame F; F.wave_id = wave_id; F.G = ogrid(); F.bx = obid(); F.vcu = (F.G % 8 == 0) ? (F.bx % 8) * (F.G / 8) + F.bx / 8 : F.bx; return F; }
#define PH_IDS() const int tid = otid(F.wave_id), lane = tid & 63, wave = F.wave_id; (void)lane; (void)wave
typedef const float* cfp_t;
struct Args { const float* in[20]; float* out; unsigned char* ws; int ph_lo, ph_hi; };
__device__ __forceinline__ unsigned opaque0() { unsigned z = 0; asm volatile("" : "+s"(z)); return z; }
__device__ __forceinline__ const float* ld_in(int i) { const __attribute__((address_space(4))) cfp_t* ka = (const __attribute__((address_space(4))) cfp_t*)__builtin_amdgcn_kernarg_segment_ptr(); return ka[i + opaque0()]; }
__device__ __forceinline__ float* ld_out() { return (float*)ld_in(20); }
__device__ __forceinline__ unsigned char* ld_ws() { return (unsigned char*)ld_in(21); }
#define WSP(T, off) ((T*)(ld_ws() + (off)))
__device__ __forceinline__ bf16* wl(int l, size_t off) { return (bf16*)(ld_ws() + WS_W + (size_t)l * W_LAYER + off); }
__device__ __forceinline__ unsigned zoff(int s, int b) { return (unsigned)((s * 16 + b) * 2048) * 128u; }
struct WQ { unsigned* base; int per_shard, shard, tried; };
__device__ __forceinline__ int wq_next(WQ& q, int lane) {
    while (q.tried < 8) {
        unsigned t = 0u; if (lane == 0) t = __hip_atomic_fetch_add(q.base + 64 * q.shard, 1u, __ATOMIC_RELAXED, __HIP_MEMORY_SCOPE_AGENT);
        const int ti = __builtin_amdgcn_readfirstlane((int)t);
        if (ti < q.per_shard) return ti * 8 + q.shard;
        q.shard = (q.shard + 1) & 7; ++q.tried;
    }
    return -1;
}
constexpr size_t CTL_WQ_COPY = 49152, CTL_WQ_NORM = 51200;
__device__ __forceinline__ float wave_sum(float v, int lane) {
#pragma unroll
    for (int o = 1; o < 64; o <<= 1) v += bperm(v, lane ^ o);
    return v;
}

__device__ __forceinline__ int win_src_col(int r) {
    const int pn = r >> 8, p = r & 255;
    if (pn < 22) { const int hs = 2 * pn + (p >> 7), pp = p & 127; const int d = 16 * (pp >> 5) + 4 * ((pp & 31) >> 3) + (pp & 3) + 64 * ((pp & 7) >> 2);
        return (hs < 24 ? hs * 128 : 3080 + (hs - 24) * 128) + d; }
    if (p < 8) return 3072 + p;
    if (p < 32) return 5640 + (p - 8);
    return -1;
}
__device__ __forceinline__ int wup_src_col(int r) { const int pn = r >> 8, p = r & 255, pp = p & 127; const int ch = (pp & ~31) | (((pp >> 2) & 1) << 4) | (((pp >> 3) & 3) << 2) | (pp & 3); return ((p >> 7) ? DFF : 0) + pn * 128 + ch; }
template <int MAP  >
__device__ __forceinline__ void p0_transpose_item(const float* W, int K, int ldw, int nblk, bf16* WT, int row_off, LAS float* scr, int item, int lane) {
    const int kb = item / nblk, nb = item % nblk, k0 = 64 * kb, n0 = 64 * nb;
    const int kr = lane >> 4, q = lane & 15, nrow = n0 + 4 * q;
    const int src = MAP == 0 ? nrow : (MAP == 1 ? win_src_col(nrow) : wup_src_col(nrow));
    f32x4 tv[16];
#pragma unroll
    for (int i = 0; i < 16; ++i) tv[i] = src >= 0 ? *(const f32x4*)(W + (size_t)(k0 + 4 * i + kr) * ldw + src) : (f32x4){0.f, 0.f, 0.f, 0.f};
#pragma unroll
    for (int i = 0; i < 16; ++i) { LAS float* d = scr + (4 * i + kr) * 65 + 4 * q; d[0] = tv[i].x; d[1] = tv[i].y; d[2] = tv[i].z; d[3] = tv[i].w; }
    LDS_WAIT(); asm volatile("" ::: "memory");
    const int c = lane & 7;
#pragma unroll
    for (int j = 0; j < 8; ++j) { const int n = (lane >> 3) + 8 * j; const LAS float* sp = scr + (8 * c) * 65 + n;
        v4u o; o.x = pk2(sp[0 * 65], sp[1 * 65]); o.y = pk2(sp[2 * 65], sp[3 * 65]); o.z = pk2(sp[4 * 65], sp[5 * 65]); o.w = pk2(sp[6 * 65], sp[7 * 65]);
        *(GAS v4u*)(WT + (size_t)(row_off + n0 + n) * K + k0 + 8 * c) = o; }
    LDS_WAIT(); asm volatile("" ::: "memory");
}
__device__ __forceinline__ void p0_prologue(Frame& F) {
    PH_IDS();
    const int blk = F.vcu;
    if (blk < 192) {
        const int l = blk / 96, n0 = (blk % 96) * 128;
        LAS float* ca = (LAS float*)LDSL;
        const float* c = ld_in(1);
        for (int i = tid; i < 16 * 2048; i += NTHREADS) { const int b = i >> 11, k = i & 2047; const float v = c[i]; ca[k * 16 + b] = v / (1.f + expf(-v)); }
        __syncthreads();
        const int hl = lane >> 5, cl = lane & 31;
        const float* W = ld_in(4) + (size_t)l * 2048 * 12288 + n0 + 4 * cl;
        f32x4 acc[16];
#pragma unroll
        for (int b = 0; b < 16; ++b) acc[b] = (f32x4){0.f, 0.f, 0.f, 0.f};
        const int kbeg = wave * 256 + hl;
#pragma unroll 8
        for (int i = 0; i < 128; ++i) {
            const int k = kbeg + 2 * i;
            const f32x4 w = *(const f32x4*)(W + (size_t)k * 12288);
            const LAS f32x4* cp = (const LAS f32x4*)(ca + k * 16);
            const f32x4 c0 = cp[0], c1 = cp[1], c2 = cp[2], c3 = cp[3];
#pragma unroll
            for (int j = 0; j < 4; ++j) { acc[j] += w * c0[j]; acc[4 + j] += w * c1[j]; acc[8 + j] += w * c2[j]; acc[12 + j] += w * c3[j]; }
        }
        __syncthreads();
        LAS float* part = (LAS float*)LDSL;
#pragma unroll
        for (int b = 0; b < 16; ++b) *(LAS f32x4*)(part + ((wave * 2 + hl) * 16 + b) * 128 + 4 * cl) = acc[b];
        __syncthreads();
        const int tid2 = otid(F.wave_id);
        for (int i = tid2; i < 16 * 128; i += NTHREADS) { const int b = i >> 7, n = i & 127; float s = 0.f;
#pragma unroll
            for (int w = 0; w < 16; ++w) s += part[(w * 16 + b) * 128 + n];
            WSP(float, WS_MOD)[((size_t)l * 16 + b) * 12288 + n0 + n] = s + ld_in(5)[(size_t)l * 12288 + n0 + n]; }
        __syncthreads();
    }
    for (int i = blk * NTHREADS + otid(F.wave_id); i < 2048 * 64; i += F.G * NTHREADS) { const int t = i >> 6, j = i & 63;
        const float inv = powf(10000.0f, -(float)(2 * j) / 128.0f); const float ang = (float)t * inv; WSP(float, WS_COS)[i] = cosf(ang); WSP(float, WS_SIN)[i] = sinf(ang); }
    { const int tidc = otid(F.wave_id); const int q = tidc >> 7, j = tidc & 127, l = q >> 1, kv = q & 1;
      for (int bb = blk; bb < 256; bb += F.G) {
          const float* pos = ld_in(8 + kv) + (size_t)l * 4096 + 16 * bb; const float* w1 = ld_in(10 + 2 * kv) + (size_t)l * 4096 * 128 + (size_t)(16 * bb) * 128 + j;
          float sacc = 0.f;
#pragma unroll
          for (int r = 0; r < 16; ++r) sacc += pos[r] * w1[(size_t)r * 128];
          WSP(float, WS_POSB)[(size_t)bb * 512 + tidc] = sacc; } }
    const int lane_d = otid(F.wave_id) & 63;
    LAS float* scr = (LAS float*)(LDSL + wave * 16896);
    const int gw = F.vcu * NWAVES + wave, NGW = F.G * NWAVES;
    constexpr int I_IN = 32 * (NINP / 64), I_OUT = 32 * 32, I_UP = 32 * (NUP / 64), I_DOWN = (DFF / 64) * 32, I_C1 = 4 * 32 * 2, I_LAYER = I_IN + I_OUT + I_UP + I_DOWN + I_C1;
    (void)gw; (void)NGW;
    constexpr int I_ALL = DEPTH * I_LAYER, CHUNK = 4, N_TICKETS = (I_ALL + CHUNK - 1) / CHUNK;
    WQ q; q.base = (unsigned*)(ld_ws() + WS_CTL + CTL_WQ_COPY); q.per_shard = (N_TICKETS + 7) / 8; q.shard = F.bx & 7; q.tried = 0;
    for (int tk = wq_next(q, lane_d), nx; tk >= 0; tk = nx) {
        nx = wq_next(q, lane_d);
        for (int it = tk * CHUNK; it < tk * CHUNK + CHUNK && it < I_ALL; ++it) {
            const int l = it / I_LAYER; int r = it % I_LAYER;
            if (r < I_IN) { p0_transpose_item<1>(ld_in(6) + (size_t)l * 2048 * DIN, 2048, DIN, NINP / 64, wl(l, W_IN), 0, scr, r, lane_d); continue; } r -= I_IN;
            if (r < I_OUT) { p0_transpose_item<0>(ld_in(14) + (size_t)l * 2048 * 2048, 2048, 2048, 32, wl(l, W_OUT), 0, scr, r, lane_d); continue; } r -= I_OUT;
            if (r < I_UP) { p0_transpose_item<2>(ld_in(15) + (size_t)l * 2048 * NUP, 2048, NUP, NUP / 64, wl(l, W_UP), 0, scr, r, lane_d); continue; } r -= I_UP;
            if (r < I_DOWN) { p0_transpose_item<0>(ld_in(18) + (size_t)l * DFF * 2048, DFF, 2048, 32, wl(l, W_DOWN), 0, scr, r, lane_d); continue; } r -= I_DOWN;
            { const int qq = r >> 6, kv = qq >> 1, half = qq & 1; r &= 63;
              const float* w1 = ld_in(10 + 2 * kv) + (size_t)l * 4096 * 128 + (size_t)half * 2048 * 128;
              p0_transpose_item<0>(w1, 2048, 128, 2, wl(l, W_C1) + (size_t)kv * 256 * 2048, half * 128, scr, r, lane_d); }
        }
    }
}

__device__ __forceinline__ void p_gate(Frame& F, int l) {
    PH_IDS();
    typedef short bf16x8_t __attribute__((ext_vector_type(8)));
    const int gw = F.vcu * NWAVES + wave, NGW = F.G * NWAVES, fr = lane & 15, fq = lane >> 4;
    const bf16* Wg = wl(l, W_IN) + (size_t)5632 * 2048 + (size_t)fr * 2048 + 32 * fq;
    const float* bfg = ld_in(7) + l * 8;
    for (int t = gw; t < MROWS / 16; t += NGW) {
        const int row = 16 * t + fr, b = row >> 11, tk = row & 2047;
        const bf16* Hp = WSP(bf16, WS_H) + (size_t)row * 2048 + 32 * fq;
        f32x4 acc0 = (f32x4){0.f, 0.f, 0.f, 0.f}, acc1 = acc0;
#pragma unroll 4
        for (int kk = 0; kk < 16; ++kk) {
            bf16x8_t hb[4], w0[4], w1[4];
#pragma unroll
            for (int q = 0; q < 4; ++q) { hb[q] = *(const bf16x8_t*)(Hp + kk * 128 + 8 * q); w0[q] = *(const bf16x8_t*)(Wg + kk * 128 + 8 * q); w1[q] = *(const bf16x8_t*)(Wg + (size_t)16 * 2048 + kk * 128 + 8 * q); }
#pragma unroll
            for (int q = 0; q < 4; ++q) {
                acc0 = __builtin_amdgcn_mfma_f32_16x16x32_bf16(w0[q], hb[q], acc0, 0, 0, 0);
                acc1 = __builtin_amdgcn_mfma_f32_16x16x32_bf16(w1[q], hb[q], acc1, 0, 0, 0); }
        }
        const float* sq = (const float*)(ld_ws() + WS_SSQ + (size_t)(2 * l) * SSQ_BYTES) + (size_t)row * 8;
        const f32x4 s0 = *(const f32x4*)sq, s1 = *(const f32x4*)(sq + 4);
        const float rstd = __builtin_amdgcn_rsqf((((s0[0] + s0[1]) + (s0[2] + s0[3])) + ((s1[0] + s1[1]) + (s1[2] + s1[3]))) * (1.0f / 2048.0f) + 1e-6f);
        const float* bp = (const float*)(ld_ws() + WS_BIAS) + ((size_t)l * 16 + b) * NINP + 5632 + 4 * fq;
        const f32x4 b0 = *(const f32x4*)bp, b1 = *(const f32x4*)(bp + 16);
        float* LOGF = WSP(float, WS_LOGF); float* G3 = WSP(float, WS_G3);
#pragma unroll
        for (int e = 0; e < 4; ++e) {
            { const int p = 4 * fq + e; const float v = acc0[e] * rstd + b0[e];
              if (p < 8) { const float x = v + bfg[p]; LOGF[(size_t)(b * 8 + p) * 2048 + tk] = fminf(x, 0.f) - __logf(1.0f + __expf(-fabsf(x))); }
              else { const int q = p - 8, h = q / 3, j = q - 3 * h; G3[(size_t)((b * 8 + h) * 3 + j) * 2048 + tk] = __builtin_amdgcn_rcpf(1.0f + __expf(-v)); } }
            { const int q = 16 + 4 * fq + e - 8, h = q / 3, j = q - 3 * h; const float v = acc1[e] * rstd + b1[e];
              G3[(size_t)((b * 8 + h) * 3 + j) * 2048 + tk] = __builtin_amdgcn_rcpf(1.0f + __expf(-v)); }
        }
    }
}
constexpr int BT_IN = NINP / 16, BT_UP = NUP / 16, BT_ALL = 2 * (BT_IN + BT_UP);
__device__ __forceinline__ void bias_task(int t, int lane) {
    typedef short bf16x8_t __attribute__((ext_vector_type(8)));
    const int fr = lane & 15, fq = lane >> 4;
    int l, r0; bool up;
    if (t < 2 * BT_IN) { up = false; l = t / BT_IN; r0 = (t % BT_IN) * 16; } else { up = true; l = (t - 2 * BT_IN) / BT_UP; r0 = ((t - 2 * BT_IN) % BT_UP) * 16; }
    const bf16* W = wl(l, up ? W_UP : W_IN) + (size_t)(r0 + fr) * 2048 + 8 * fq;
    const float* sh = WSP(float, WS_MOD) + ((size_t)l * 16 + fr) * 12288 + (up ? 3 : 0) * 2048 + 8 * fq;
    f32x4 acc = (f32x4){0.f, 0.f, 0.f, 0.f};
#pragma unroll 8
    for (int kt = 0; kt < 64; ++kt) {
        const bf16x8_t a = *(const bf16x8_t*)(W + kt * 32);
        const f32x4 s0 = *(const f32x4*)(sh + kt * 32), s1 = *(const f32x4*)(sh + kt * 32 + 4);
        v4u pb; pb.x = pk2(s0.x, s0.y); pb.y = pk2(s0.z, s0.w); pb.z = pk2(s1.x, s1.y); pb.w = pk2(s1.z, s1.w);
        acc = __builtin_amdgcn_mfma_f32_16x16x32_bf16(a, __builtin_bit_cast(bf16x8_t, pb), acc, 0, 0, 0);
    }
    float* out = (float*)(ld_ws() + WS_BIAS + (up ? BIAS_UP_OFF : 0)) + ((size_t)l * 16 + fr) * (up ? NUP : NINP) + r0 + 4 * fq;
    *(f32x4*)out = acc;
}
__device__ __forceinline__ void p_phase1(Frame& F, const float* x, const float* g, const float* mod_l, int sc_chunk, bf16* H, float* ssq) {
    PH_IDS();
    const int gw = F.vcu * NWAVES + wave, NGW = F.G * NWAVES;
    if (gw < BT_ALL) bias_task(gw, lane);
    const int nb_extra = BT_ALL > NGW ? BT_ALL - NGW : 0;
    if (NGW < BT_ALL - nb_extra) return;
    WQ q; q.base = (unsigned*)(ld_ws() + WS_CTL + CTL_WQ_NORM); q.per_shard = (nb_extra + MROWS / 4 + 7) / 8; q.shard = F.bx & 7; q.tried = 0;
    for (int tk = wq_next(q, lane), nx; tk >= 0; tk = nx) {
        nx = wq_next(q, lane);
        if (tk < nb_extra) { bias_task(NGW + tk, lane); continue; }
        const int m0 = 4 * (tk - nb_extra); if (m0 >= MROWS) continue;
        const int b = m0 >> 11;
        f32x4 v[4][8];
#pragma unroll
        for (int r = 0; r < 4; ++r) { const f32x4* xr = (const f32x4*)(x + (size_t)(m0 + r) * DM) + lane;
#pragma unroll
            for (int j = 0; j < 8; ++j) v[r][j] = xr[64 * j]; }
        const f32x4* gp = (const f32x4*)g + lane; const f32x4* scp = (const f32x4*)(mod_l + (size_t)b * 12288 + sc_chunk * 2048) + lane;
        f32x4 gs[8];
#pragma unroll
        for (int j = 0; j < 8; ++j) gs[j] = gp[64 * j] * (scp[64 * j] + 1.0f);
        float tot[4];
#pragma unroll
        for (int r = 0; r < 4; ++r) { float sacc = 0.f;
#pragma unroll
            for (int j = 0; j < 8; ++j) sacc += (v[r][j].x * v[r][j].x + v[r][j].y * v[r][j].y) + (v[r][j].z * v[r][j].z + v[r][j].w * v[r][j].w);
            tot[r] = sacc; }
#pragma unroll
        for (int o = 1; o < 64; o <<= 1) {
#pragma unroll
            for (int r = 0; r < 4; ++r) tot[r] += bperm(tot[r], lane ^ o); }
#pragma unroll
        for (int r = 0; r < 4; ++r) { v2u* o8 = (v2u*)(H + (size_t)(m0 + r) * DM) + lane;
#pragma unroll
            for (int j = 0; j < 8; ++j) { const f32x4 y = v[r][j] * gs[j]; v2u w; w.x = pk2(y.x, y.y); w.y = pk2(y.z, y.w); o8[64 * j] = w; }
            if (lane < 8) ssq[(size_t)(m0 + r) * 8 + lane] = lane == 0 ? tot[r] : 0.f; }
    }
}
__device__ __forceinline__ void p_final_norm(Frame& F, const float* g, const bf16* xb, float* out) {
    PH_IDS();
    const int gw = F.vcu * NWAVES + wave, NGW = F.G * NWAVES;
    v2u v[8], vn[8]; f32x4 gg[8];
#pragma unroll
    for (int j = 0; j < 8; ++j) gg[j] = *(const f32x4*)(g + 256 * j + 4 * lane);
    if (gw < MROWS) { const bf16* xr = xb + (size_t)gw * DM + 4 * lane;
#pragma unroll
        for (int j = 0; j < 8; ++j) v[j] = *(const v2u*)(xr + 256 * j); }
    for (int m = gw; m < MROWS; m += NGW) {
        if (m + NGW < MROWS) { const bf16* xr = xb + (size_t)(m + NGW) * DM + 4 * lane;
#pragma unroll
            for (int j = 0; j < 8; ++j) vn[j] = *(const v2u*)(xr + 256 * j); }
        f32x4 x[8]; float s = 0.f;
#pragma unroll
        for (int j = 0; j < 8; ++j) { const v2u w = v[j];
            x[j] = (f32x4){__builtin_bit_cast(float, w.x << 16), __builtin_bit_cast(float, w.x & 0xffff0000u), __builtin_bit_cast(float, w.y << 16), __builtin_bit_cast(float, w.y & 0xffff0000u)};
            s += (x[j].x * x[j].x + x[j].y * x[j].y) + (x[j].z * x[j].z + x[j].w * x[j].w); }
        const float rstd = 1.0f / sqrtf(wave_sum(s, lane) * (1.0f / DM) + RMS_EPS);
        float* xw = out + (size_t)m * DM + 4 * lane;
#pragma unroll
        for (int j = 0; j < 8; ++j) *(f32x4*)(xw + 256 * j) = (x[j] * rstd) * gg[j];
#pragma unroll
        for (int j = 0; j < 8; ++j) v[j] = vn[j];
    }
}

__device__ __forceinline__ void p_cumsum(Frame& F, const float* LOGF, float* KBIAS) {
    PH_IDS();
    const int gw = F.vcu * NWAVES + wave, NGW = F.G * NWAVES;
    for (int u = gw; u < 128; u += NGW) {
        const float* lf = LOGF + (size_t)u * 2048 + 32 * lane; float* kb = KBIAS + (size_t)u * 2048 + 32 * lane;
        float v[32];
#pragma unroll
        for (int j = 0; j < 8; ++j) { const f32x4 x = *(const f32x4*)(lf + 4 * j); v[4 * j] = x.x; v[4 * j + 1] = x.y; v[4 * j + 2] = x.z; v[4 * j + 3] = x.w; }
#pragma unroll
        for (int j = 1; j < 32; ++j) v[j] += v[j - 1];
        float tot = v[31], inc = tot;
#pragma unroll
        for (int o = 1; o < 64; o <<= 1) { const float t = bperm(inc, lane >= o ? lane - o : lane); if (lane >= o) inc += t; }
        const float base = inc - tot;
#pragma unroll
        for (int j = 0; j < 8; ++j) { f32x4 y; y.x = -(v[4 * j] + base) * 11.313708498984761f; y.y = -(v[4 * j + 1] + base) * 11.313708498984761f; y.z = -(v[4 * j + 2] + base) * 11.313708498984761f; y.w = -(v[4 * j + 3] + base) * 11.313708498984761f;
            *(f32x4*)(kb + 4 * j) = y; }
    }
}

__device__ __forceinline__ void p_compress2_unit(Frame& F, int l, int unit) {
    PH_IDS();
    const int kv = unit >> 7, bk = (unit >> 2) & 31, qt = unit & 3, b = bk >> 1, hkv = bk & 1, n0 = 32 * qt;
    LAS float* hid = (LAS float*)LDSL;
    LAS float* w2s = (LAS float*)(LDSL + 32 * 129 * 4 + 16);
    const float* T1 = WSP(float, WS_T1) + (size_t)kv * 4096 * 256 + (size_t)((hkv * 16 + b) * 128) * 256;
    const float* pp = WSP(float, WS_POSB) + (l * 2 + kv) * 128;
    const float* w2 = ld_in(11 + 2 * kv) + (size_t)l * 128 * 128;
    LAS float* posb = w2s;
    f32x4 wreg[8];
#pragma unroll
    for (int q = 0; q < 8; ++q) wreg[q] = *(const f32x4*)(w2 + 4 * (tid + NTHREADS * q));
    float t1a[8], t1b[8];
#pragma unroll
    for (int it = 0; it < 8; ++it) { const int i = tid + NTHREADS * it, nl = i >> 7, j = i & 127, n = n0 + nl; t1a[it] = 0.f; t1b[it] = 0.f;
        if (n < 127) { t1a[it] = T1[(size_t)n * 256 + j]; t1b[it] = T1[(size_t)(n + 1) * 256 + 128 + j]; } }
    { const int j = tid & 127, part = tid >> 7; float sp0 = 0.f, sp1 = 0.f, sp2 = 0.f, sp3 = 0.f;
#pragma unroll
      for (int q = 0; q < 64; q += 4) { const float* pq = pp + (size_t)(part * 64 + q) * 512 + j; sp0 += pq[0]; sp1 += pq[512]; sp2 += pq[1024]; sp3 += pq[1536]; }
      posb[part * 128 + j] = (sp0 + sp1) + (sp2 + sp3); }
    __syncthreads();
#pragma unroll
    for (int it = 0; it < 8; ++it) { const int i = tid + NTHREADS * it, nl = i >> 7, j = i & 127, n = n0 + nl;
        float hv = 0.f;
        if (n < 127) { const float x = t1a[it] + t1b[it] + ((posb[j] + posb[128 + j]) + (posb[256 + j] + posb[384 + j]));
            const float u = 0.7978845608028654f * (x + 0.044715f * x * x * x); hv = 0.5f * x * (1.0f + tanhf(u)); }
        hid[nl * 129 + j] = hv; }
    __syncthreads();
#pragma unroll
    for (int q = 0; q < 8; ++q) *(LAS f32x4*)(w2s + 4 * (tid + NTHREADS * q)) = wreg[q];
    __syncthreads();
    const int nl = tid >> 4, eg = tid & 15, n = n0 + nl;
    float acc[8];
#pragma unroll
    for (int e = 0; e < 8; ++e) acc[e] = 0.f;
#pragma unroll 4
    for (int j = 0; j < 128; ++j) { const float h = hid[nl * 129 + j]; const LAS f32x4* wp = (const LAS f32x4*)(w2s + j * 128 + eg * 8);
        const f32x4 wa = wp[0], wb = wp[1];
        acc[0] += h * wa.x; acc[1] += h * wa.y; acc[2] += h * wa.z; acc[3] += h * wa.w; acc[4] += h * wb.x; acc[5] += h * wb.y; acc[6] += h * wb.z; acc[7] += h * wb.w; }
    if (kv == 0) { v4u w; w.x = pk2(acc[0], acc[1]); w.y = pk2(acc[2], acc[3]); w.z = pk2(acc[4], acc[5]); w.w = pk2(acc[6], acc[7]);
        *(v4u*)(WSP(bf16, WS_KCMP) + ((size_t)bk * 128 + n) * 128 + eg * 8) = w; }
    else { bf16* o = WSP(bf16, WS_VCMPT) + (size_t)bk * 128 * 128 + n;
#pragma unroll
        for (int e = 0; e < 8; ++e) o[(size_t)(eg * 8 + e) * 128] = (bf16)f2bf(acc[e]); }
    __syncthreads();
}

constexpr int CMP_TILE = 16384;
__device__ __forceinline__ void p_cmp_super(Frame& F, int su, const float gscale  ) {
    PH_IDS();
    const int bk = su >> 3, b = bk >> 1, hkv = bk & 1;
    const int wid = wave, r32 = lane & 31, hi = lane >> 5;
    char* ldsb = (char*)g_lds;
    { const int sr = tid >> 4, sc = (tid & 15) * 8, kws = KSWZ(sr, sc * 2);
      const bf16* Kc = WSP(bf16, WS_KCMP) + (size_t)bk * 128 * 128; const bf16* Vt = WSP(bf16, WS_VCMPT) + (size_t)bk * 128 * 128;
      bf16x8 t[8];
#pragma unroll
      for (int q = 0; q < 4; ++q) { const bf16* src = (q < 2 ? Kc : Vt) + (size_t)(64 * (q & 1)) * 128; t[2 * q] = *(const bf16x8*)(src + (size_t)sr * 128 + sc); t[2 * q + 1] = *(const bf16x8*)(src + (size_t)(32 + sr) * 128 + sc); }
#pragma unroll
      for (int q = 0; q < 4; ++q) { *(bf16x8*)(ldsb + q * CMP_TILE + kws) = t[2 * q]; *(bf16x8*)(ldsb + q * CMP_TILE + kws + 32 * 256) = t[2 * q + 1]; } }
    __syncthreads();
    constexpr float C2 = 1.4426950408889634f * att::SCALE; const float NEG = -__builtin_inff();
    const int tq = (su & 7) * 256 + wid * 32 + r32;
    int nvalid = 0; if (tq >= 31) { nvalid = (tq - 31) / 16 + 1; if (nvalid > 127) nvalid = 127; }
    float imp[16];
#pragma unroll
    for (int q = 0; q < 16; ++q) imp[q] = 0.f;
#pragma unroll 1
    for (int g = 0; g < 4; ++g) {
        const int h = 4 * hkv + g;
        const bf16* Qp = WSP(bf16, WS_Z) + zoff(24 + h, b) + (size_t)tq * 128;
        bf16x8 qr[8];
#pragma unroll
        for (int d0 = 0; d0 < 8; ++d0) qr[d0] = *(const bf16x8*)(Qp + d0 * 16 + hi * 8);
        const float g0 = WSP(float, WS_G3)[(size_t)((b * 8 + h) * 3 + 0) * 2048 + tq] * gscale;
        att::f32x16 p[4];
        att::qkt<0, false>(p[0], p[1], ldsb, r32, hi, qr, true);
        att::qkt<1, false>(p[2], p[3], ldsb, r32, hi, qr, true);
        float mx = NEG; int nv = nvalid; asm volatile("" : "+v"(nv));
#pragma unroll
        for (int kg = 0; kg < 4; ++kg)
#pragma unroll
            for (int r = 0; r < 16; ++r) { const int key = 32 * kg + crow(r, hi); const float sv = key < nv ? p[kg][r] * C2 : NEG; p[kg][r] = sv; mx = fmaxf(mx, sv); }
        { auto rr = __builtin_amdgcn_permlane32_swap(__float_as_uint(mx), __float_as_uint(mx), false, false); mx = fmaxf(__uint_as_float(rr[0]), __uint_as_float(rr[1])); }
        const float ms = nvalid > 0 ? mx : 0.f;
        float sum = 0.f;
#pragma unroll
        for (int kg = 0; kg < 4; ++kg)
#pragma unroll
            for (int r = 0; r < 16; ++r) { const float e = __builtin_amdgcn_exp2f(p[kg][r] - ms); p[kg][r] = e; sum += e; }
        { auto rr = __builtin_amdgcn_permlane32_swap(__float_as_uint(sum), __float_as_uint(sum), false, false); sum = __uint_as_float(rr[0]) + __uint_as_float(rr[1]); }
        const float inv = nvalid > 0 ? 1.0f / sum : 0.f;
#pragma unroll
        for (int kg = 0; kg < 4; ++kg)
#pragma unroll
            for (int a = 0; a < 4; ++a) imp[4 * kg + a] += ((p[kg][4 * a] + p[kg][4 * a + 1]) + (p[kg][4 * a + 2] + p[kg][4 * a + 3])) * inv;
        const float scl = inv * g0;
#pragma unroll
        for (int kg = 0; kg < 4; ++kg)
#pragma unroll
            for (int r = 0; r < 16; ++r) p[kg][r] *= scl;
        bf16x8 pa[8];
#pragma unroll
        for (int kg = 0; kg < 4; ++kg) { ATT_PK4(p[kg], 0, pa[2 * kg]); ATT_PK4(p[kg], 8, pa[2 * kg + 1]); }
        int hi_e = hi, r32_e = r32; asm volatile("" : "+v"(hi_e), "+v"(r32_e));
        const int le = hi_e * 32 + r32_e, rrow = le >> 4, cb = (le & 15) * 16;
        bf16* Og = WSP(bf16, WS_O) + ((size_t)(b * 2048 + (su & 7) * 256 + wid * 32 + rrow)) * 2048 + 1024 + h * 128 + (cb >> 1);
        att::u32x4 sv[8], old[8];
#pragma unroll
        for (int j = 0; j < 8; ++j) old[j] = *(const att::u32x4*)(Og + (size_t)(4 * j) * 2048);
        att::f32x16 o[4];
#pragma unroll
        for (int d0 = 0; d0 < 4; ++d0) { o[d0] = att::f32x16{};
            const char* vbase = ldsb + (2 + (d0 >> 1)) * CMP_TILE;
#pragma unroll
            for (int ks = 0; ks < 8; ++ks) { const bf16x8 vb = *(const bf16x8*)(vbase + KSWZ(32 * (d0 & 1) + r32, 32 * ks + 16 * hi)); o[d0] = __builtin_amdgcn_mfma_f32_32x32x16_bf16(pa[ks], vb, o[d0], 0, 0, 0); } }
        {
            char* stg = ldsb + 73728 + wid * 8704; char* wp = stg + (4 * hi_e) * 272 + r32_e * 2;
#pragma unroll
            for (int d0 = 0; d0 < 4; ++d0) {
                float n16[16];
#pragma unroll
                for (int r = 0; r < 16; ++r) n16[r] = dpp_xor1(o[d0][r]);
                if ((r32 & 1) == 0) {
#pragma unroll
                    for (int r = 0; r < 16; ++r) *(unsigned*)(wp + crow(r, 0) * 272 + d0 * 64) = cvtpk(o[d0][r], n16[r]);
                }
            }
            asm volatile("s_waitcnt lgkmcnt(0)" ::: "memory");
            const char* rp = stg + rrow * 272 + cb;
#pragma unroll
            for (int j = 0; j < 8; ++j) sv[j] = *(const att::u32x4*)(rp + (4 * j) * 272);
#pragma unroll
            for (int j = 0; j < 8; ++j) { att::u32x4 w;
#pragma unroll
                for (int e = 0; e < 4; ++e) w[e] = cvtpk(__uint_as_float(sv[j][e] << 16) + __uint_as_float(old[j][e] << 16), __uint_as_float(sv[j][e] & 0xffff0000u) + __uint_as_float(old[j][e] & 0xffff0000u));
                *(att::u32x4*)(Og + (size_t)(4 * j) * 2048) = w; }
        }
    }
    { const int cur = tq >> 6;
      float own[16], oth[16];
#pragma unroll
      for (int q = 0; q < 16; ++q) { auto rr = __builtin_amdgcn_permlane32_swap(__float_as_uint(imp[q]), __float_as_uint(imp[q]), false, false);
          const float lo_v = __uint_as_float(rr[0]), hi_v = __uint_as_float(rr[1]);
          const float ot = hi ? lo_v : hi_v;
          const int jv = 2 * q + hi, jo = 2 * q + 1 - hi;
          own[q] = (jv <= cur) ? imp[q] + (((jv == 0) || (jv == cur) || (jv == cur - 1)) ? 1000.0f : 0.0f) : -1e30f;
          oth[q] = (jo <= cur) ? ot + (((jo == 0) || (jo == cur) || (jo == cur - 1)) ? 1000.0f : 0.0f) : -1e30f; }
      unsigned bits = 0u;
#define CNT_GT(x) asm("v_cmp_gt_f32 vcc, %1, %2\n\tv_addc_co_u32 %0, vcc, 0, %0, vcc" : "+v"(cnt) : "v"(x), "v"(sj) : "vcc")
#define CNT_EQ(x) asm("v_cmp_eq_f32 vcc, %1, %2\n\tv_addc_co_u32 %0, vcc, 0, %0, vcc" : "+v"(cnt) : "v"(x), "v"(sj) : "vcc")
#pragma unroll
      for (int q = 0; q < 16; ++q) { const float sj = own[q]; int cnt = 0;
#pragma unroll
          for (int i = 0; i < 16; ++i) { CNT_GT(own[i]); CNT_GT(oth[i]); if (i < q) { CNT_EQ(own[i]); CNT_EQ(oth[i]); } }
          cnt += (oth[q] == sj && hi != 0) ? 1 : 0;
          bits |= (cnt < 16 ? 1u : 0u) << (2 * q); }
#undef CNT_GT
#undef CNT_EQ
      const unsigned half = bits << hi;
      auto rr = __builtin_amdgcn_permlane32_swap(half, half, false, false);
      if (hi == 0) WSP(unsigned, WS_SELM)[(size_t)bk * 2048 + tq] = rr[0] | rr[1]; }
    __syncthreads();
}

template <int MODE>
__device__ __forceinline__ att::BlockRef att_ref(int idx) {
    const int qb = 7 - (idx >> 7), j = idx & 127;
    const int b = (MODE == 0) ? (j >> 3) : ((j & 31) >> 1), h = (MODE == 0) ? (j & 7) : (4 * (j & 1) + (j >> 5)), bh = b * 8 + h;
    att::BlockRef r; r.P0 = qb * 256; r.x = 0; r.s = 0;
    const unsigned qoff = (unsigned)qb * 256u * 128u;
    if (MODE == 0) { r.q = zoff(h, b) + qoff; r.k = zoff(8 + h, b); r.v = zoff(16 + h, b); r.o = (unsigned)(b * 2048 + qb * 256) * 2048u + h * 128; r.x = (unsigned)bh * 2048u; }
    else { const int hk = h >> 2;
        r.q = zoff(24 + h, b) + qoff; r.k = zoff((MODE == 1 ? 40 : 36) + hk, b); r.v = zoff((MODE == 1 ? 42 : 38) + hk, b);
        r.o = (unsigned)(b * 2048 + qb * 256) * 2048u + 1024 + h * 128;
        r.x = (unsigned)(bh * 3 + (MODE == 1 ? 2 : 1)) * 2048u; r.s = (unsigned)(b * 2 + hk) * 2048u; }
    return r;
}
__device__ __forceinline__ int att_item(int c, int G, int r) { return r * G + ((r & 1) ? G - 1 - c : c); }
__device__ __forceinline__ int fox_item(int c, int G, int r) {
    if (G != 256) return r * G + ((r & 1) ? G - 1 - c : c);
    if (r > 3) return 1024;
    const int x = c & 7, w = c >> 3, j = 16 * x + 8 * (r >> 1) + (w >> 2), qb = (r & 1) ? (w & 3) : 7 - (w & 3);
    return (7 - qb) * 128 + j;
}
__device__ __forceinline__ int win_item(int c, int G, int r) {
    if (G != 256) return att_item(c, G, r);
    const int cq = (c & 31) + 32 * (c >> 7), g = (c >> 5) & 3;
    int qb, bk;
    if (cq < 8) { if (r == 0) { qb = 7; bk = cq; } else if (r == 1) { qb = 1; bk = cq; } else return 1024; }
    else { const int k = cq - 8;
        if (r < 3) { const int t = 8 + 3 * k + r; qb = 7 - (t >> 5); bk = t & 31; }
        else if (k < 16) { if (r != 3) return 1024; const int t = 176 + k; qb = 7 - (t >> 5); bk = t & 31; }
        else if (k < 40) { if (r != 3) return 1024; qb = 1; bk = 8 + (k - 16); }
        else { if (r > 4) return 1024; qb = 0; bk = 2 * (k - 40) + (r - 3); } }
    return (7 - qb) * 128 + g * 32 + bk;
}
__device__ __forceinline__ int cmp1_slot(int c, int G) { if (G != 256) return c < 32 ? c : -1; return (c < 128 && (c & 31) < 8) ? (c & 31) + 8 * (c >> 5) : -1; }
template <int MODE, int VAR = 0>
__device__ __forceinline__ void p_attention(Frame& F, const bool st = true) {
    const int c = F.bx, G = F.G; const int tid = otid(F.wave_id);
    int r = 0; int idx = (MODE == 1) ? win_item(c, G, 0) : (MODE == 0 ? fox_item(c, G, 0) : att_item(c, G, 0)); if (idx >= 1024) return;
    att::Bases BS; BS.Zb = (const att::bf16*)WSP(bf16, WS_Z); BS.Ob = (att::bf16*)WSP(bf16, WS_O); BS.Xf = (MODE == 0) ? WSP(float, WS_KBIAS) : WSP(float, WS_G3); BS.Sel = WSP(unsigned, WS_SELM); BS.st = st;
    att::BlockRef cur = att_ref<MODE>(idx);
    att::Seam S;
    att::att_prime<MODE, VAR>(BS, cur, (char*)g_lds, S, tid);
    for (;;) {
        const int nidx = (MODE == 1) ? win_item(c, G, r + 1) : (MODE == 0 ? fox_item(c, G, r + 1) : att_item(c, G, r + 1)); const bool last = nidx >= 1024;
        const att::BlockRef nxt = last ? cur : att_ref<MODE>(nidx);
        att::att_block<MODE, VAR>(BS, cur, nxt, SEQ, (char*)g_lds, S, tid);
        if (last) break;
        cur = nxt; ++r;
    }
}

__device__ __forceinline__ f32x4 ld_bf4(const bf16* p) { const v2u w = *(const v2u*)p; f32x4 r; r.x = __builtin_bit_cast(float, w.x << 16); r.y = __builtin_bit_cast(float, w.x & 0xffff0000u); r.z = __builtin_bit_cast(float, w.y << 16); r.w = __builtin_bit_cast(float, w.y & 0xffff0000u); return r; }
__device__ __forceinline__ void p_fixup(Frame& F, int l) {
    PH_IDS();
    const float* cw = ld_in(16) + (size_t)l * 3 * NUP; const float* cb = ld_in(17) + (size_t)l * NUP; const bf16* SIDE = WSP(bf16, WS_SIDE); bf16* ACT = WSP(bf16, WS_ACT);
    const int NC = DFF / 4, NT_ = F.G * NTHREADS, NS = NT_ / NC;
    const int gt = F.vcu * NTHREADS + tid; const int jc = gt % NC, gslot = gt / NC;
    if (gslot >= NS) return;
    const int j = 4 * jc;
    f32x4 w0[2], w1[2], w2[2], bb[2];
#pragma unroll
    for (int q = 0; q < 2; ++q) { const int col = q * DFF + j; w0[q] = *(const f32x4*)(cw + col); w1[q] = *(const f32x4*)(cw + NUP + col); w2[q] = *(const f32x4*)(cw + 2 * NUP + col); bb[q] = *(const f32x4*)(cb + col); }
#pragma unroll 2
    for (int grp = gslot; grp < 512; grp += NS) {
        if ((grp & 31) == 0) continue;
        const bf16* sp = SIDE + (size_t)(grp - 1) * 4 * NUP; const bf16* sc = SIDE + (size_t)grp * 4 * NUP;
        f32x4 y0[2], y1[2];
#pragma unroll
        for (int q = 0; q < 2; ++q) { const int col = q * DFF + j;
            const f32x4 um2 = ld_bf4(sp + 2 * NUP + col), um1 = ld_bf4(sp + 3 * NUP + col), u0 = ld_bf4(sc + col), u1 = ld_bf4(sc + NUP + col);
            y0[q] = bb[q] + w0[q] * um2 + w1[q] * um1 + w2[q] * u0; y1[q] = bb[q] + w0[q] * um1 + w1[q] * u0 + w2[q] * u1; }
        f32x4 a0, a1;
#pragma unroll
        for (int e = 0; e < 4; ++e) { a0[e] = y0[0][e] * pg8::fast_sigmoid(y0[0][e]) * y0[1][e]; a1[e] = y1[0][e] * pg8::fast_sigmoid(y1[0][e]) * y1[1][e]; }
        v2u o0, o1; o0.x = pg8::cvt_pk_bf16(a0[0], a0[1]); o0.y = pg8::cvt_pk_bf16(a0[2], a0[3]); o1.x = pg8::cvt_pk_bf16(a1[0], a1[1]); o1.y = pg8::cvt_pk_bf16(a1[2], a1[3]);
        *(v2u*)(ACT + (size_t)(grp * 64) * DFF + j) = o0; *(v2u*)(ACT + (size_t)(grp * 64 + 1) * DFF + j) = o1;
    }
}

constexpr int NPH_LAYER = 11, NPH = 1 + DEPTH * NPH_LAYER + 1;
#ifndef MK_PHASE_MASK
#define MK_PHASE_MASK 0xffffffffu
#endif
#ifndef MK_SUB
#define MK_SUB 7
#endif
#define ON(j) ((MK_PHASE_MASK >> (j)) & 1u)
#ifndef MK_REP_MASK
#define MK_REP_MASK 0u
#endif
#define NREP(j) (((MK_REP_MASK >> (j)) & 1u) ? 2 : 1)
__global__ void __launch_bounds__(NTHREADS, 2) mk_fwd(Args args) {
    const int wave_id = __builtin_amdgcn_readfirstlane((int)threadIdx.x >> 6);
    volatile LAS unsigned* MISC = (volatile LAS unsigned*)(LDSL + MISC_OFF);
    for (int u = threadIdx.x; u < (LDS_BYTES - MISC_OFF) / 4; u += NTHREADS) MISC[u] = 0u;
    __syncthreads();
    const int lo = args.ph_lo, hi = args.ph_hi;
    const bool multi = (hi - lo) > 1;
    if (multi) (void)xcd_barrier_post((unsigned*)(ld_ws() + WS_CTL) + CW_BAR, MISC + 8);
#define IN(k) (lo <= (k) && (k) < hi)
#define FBAR() do { XcdBarrier b_; b_.bar = (unsigned*)(ld_ws() + WS_CTL) + CW_BAR; b_.x = xb_xcc_id(); b_.st = MISC + 8; xcd_barrier(b_, otid(wave_id) == 0); } while (0)
#define REP_BEGIN(j) for (int rep_ = 0; rep_ < NREP(j); ++rep_) { if (rep_) FBAR();
#define REP_END }
#define SEAM(k) do { if (IN(k) && IN((k) + 1)) { XcdBarrier b_; b_.bar = (unsigned*)(ld_ws() + WS_CTL) + CW_BAR; b_.x = xb_xcc_id(); b_.st = MISC + 8; xcd_barrier(b_, otid(wave_id) == 0); } } while (0)

#ifdef MK_EXTRA_BARRIERS
    for (int eb_ = 0; eb_ < MK_EXTRA_BARRIERS; ++eb_) FBAR();
#endif
    REP_BEGIN(0) if (ON(0) && IN(0)) { Frame F = mkframe(wave_id); p0_prologue(F); } REP_END SEAM(0);
    for (int l = 0; l < DEPTH; ++l) {
        const int pb = 1 + l * NPH_LAYER;
        const size_t modl = WS_MOD + (size_t)l * 16 * 12288 * 4;
        if (l == 0) { REP_BEGIN(1) if (ON(1) && IN(pb + 0)) { Frame F = mkframe(wave_id); p_phase1(F, ld_in(0), ld_in(2), WSP(float, WS_MOD), 1, WSP(bf16, WS_H), WSP(float, WS_SSQ)); } REP_END SEAM(pb + 0); }
        REP_BEGIN(2) if (ON(2) && IN(pb + 1)) { Frame F = mkframe(wave_id);
            pg8::Gemm g{WSP(bf16, WS_H), wl(l, W_IN), MROWS, 5632, DM}; pg8::StaticOrder S; S.init(MROWS, 5632, F.G, F.bx);
            pg8::EpiInProj E{ld_ws(), (const float*)(ld_ws() + WS_SSQ + (size_t)(2 * l) * SSQ_BYTES), (const float*)(ld_ws() + WS_BIAS) + (size_t)l * 16 * NINP};
            pg8::gemm_phase<pg8::EpiInProj, pg8::StaticOrder, true, true>(LDSL, g, S, E, otid(wave_id));
            p_gate(F, l);
        } REP_END SEAM(pb + 1);
        REP_BEGIN(3) if (ON(3) && IN(pb + 2)) { Frame F = mkframe(wave_id);
            if (MK_SUB & 1) {
            { pg8::Gemm g{WSP(bf16, WS_Z) + zoff(32, 0), wl(l, W_C1), 4096, 256, DM}; const int slot = cmp1_slot(F.bx, F.G); pg8::StaticOrder S; S.init(4096, 256, F.G, F.G != 256 ? F.bx : ((slot >= 0 && slot < 16) ? slot : 16));
              pg8::EpiF32 E{WSP(float, WS_T1), 256}; pg8::gemm_phase<pg8::EpiF32, pg8::StaticOrder, true, true>(LDSL, g, S, E, otid(wave_id)); }
            { pg8::Gemm g{WSP(bf16, WS_Z) + zoff(34, 0), wl(l, W_C1) + (size_t)256 * 2048, 4096, 256, DM}; const int slot = cmp1_slot(F.bx, F.G); pg8::StaticOrder S; S.init(4096, 256, F.G, F.G != 256 ? F.bx : (slot >= 16 ? slot - 16 : 16));
              pg8::EpiF32 E{WSP(float, WS_T1) + (size_t)4096 * 256, 256}; pg8::gemm_phase<pg8::EpiF32, pg8::StaticOrder, true, true>(LDSL, g, S, E, otid(wave_id)); }
            }
            if (MK_SUB & 2) p_cumsum(F, WSP(float, WS_LOGF), WSP(float, WS_KBIAS));
            __syncthreads();
            if (MK_SUB & 4) p_attention<1>(F);
        } REP_END SEAM(pb + 2);
        REP_BEGIN(4) if (ON(4) && IN(pb + 3)) { Frame F = mkframe(wave_id);
            if (MK_SUB & 1) for (int u = F.vcu; u < 256; u += F.G) p_compress2_unit(F, l, u);
#ifdef MK_FOX_VAR
            if (rep_ + 1 < NREP(4)) { p_attention<0, MK_FOX_VAR>(F, false); } else
#endif
            if (MK_SUB & 4) p_attention<0>(F);
        } REP_END SEAM(pb + 3);
        REP_BEGIN(5) if (ON(5) && IN(pb + 4)) { Frame F = mkframe(wave_id); for (int u = F.bx; u < 256; u += F.G) p_cmp_super(F, u, rep_ == NREP(5) - 1 ? 1.0f : 0.0f); } REP_END SEAM(pb + 4);
        REP_BEGIN(6) if (ON(6) && IN(pb + 5)) { Frame F = mkframe(wave_id); p_attention<2>(F, rep_ == NREP(6) - 1); } REP_END SEAM(pb + 5);
        REP_BEGIN(7) if (ON(7) && IN(pb + 6)) { Frame F = mkframe(wave_id);
            pg8::Gemm g{WSP(bf16, WS_O), wl(l, W_OUT), MROWS, DM, DM}; pg8::StaticOrder S; S.init(MROWS, DM, F.G, F.bx);
            if (l == 0) {
                pg8::EpiRes<true, false> E{ld_in(0), WSP(bf16, WS_XB), (const float*)(ld_ws() + modl) + 2 * 2048, rep_ == NREP(7) - 1,
                                    WSP(bf16, WS_H), ld_in(3) + (size_t)l * DM, (const float*)(ld_ws() + modl) + 4 * 2048, (float*)(ld_ws() + WS_SSQ + (size_t)(2 * l + 1) * SSQ_BYTES), (LAS float*)(LDSL + 131072)};
                pg8::gemm_phase<pg8::EpiRes<true, false>, pg8::StaticOrder, true, true>(LDSL, g, S, E, otid(wave_id));
            } else {
                pg8::EpiRes<true, true> E{WSP(bf16, WS_XB), WSP(bf16, WS_XB), (const float*)(ld_ws() + modl) + 2 * 2048, rep_ == NREP(7) - 1,
                                    WSP(bf16, WS_H), ld_in(3) + (size_t)l * DM, (const float*)(ld_ws() + modl) + 4 * 2048, (float*)(ld_ws() + WS_SSQ + (size_t)(2 * l + 1) * SSQ_BYTES), (LAS float*)(LDSL + 131072)};
                pg8::gemm_phase<pg8::EpiRes<true, true>, pg8::StaticOrder, true, true>(LDSL, g, S, E, otid(wave_id));
            }
        } REP_END SEAM(pb + 6);
        REP_BEGIN(9) if (ON(9) && IN(pb + 8)) { Frame F = mkframe(wave_id);
            pg8::Gemm g{WSP(bf16, WS_H), wl(l, W_UP), MROWS, NUP, DM}; pg8::StaticOrder S; S.init(MROWS, NUP, F.G, F.bx);
            pg8::EpiConvGate E{WSP(bf16, WS_ACT), WSP(bf16, WS_SIDE), ld_in(16) + (size_t)l * 3 * NUP, ld_in(17) + (size_t)l * NUP,
                               (const float*)(ld_ws() + WS_SSQ + (size_t)(2 * l + 1) * SSQ_BYTES), (const float*)(ld_ws() + WS_BIAS + BIAS_UP_OFF) + (size_t)l * 16 * NUP, LDSL + 131072};
            pg8::gemm_phase<pg8::EpiConvGate, pg8::StaticOrder, true, true>(LDSL, g, S, E, otid(wave_id));
        } REP_END SEAM(pb + 8);
        REP_BEGIN(10) if (ON(10) && IN(pb + 9)) { Frame F = mkframe(wave_id); p_fixup(F, l); } REP_END SEAM(pb + 9);
        REP_BEGIN(11) if (ON(11) && IN(pb + 10)) { Frame F = mkframe(wave_id);
            pg8::Gemm g{WSP(bf16, WS_ACT), wl(l, W_DOWN), MROWS, DM, DFF}; pg8::StaticOrder S; S.init(MROWS, DM, F.G, F.bx);
            if (l + 1 < DEPTH) {
                pg8::EpiRes<true, true> E{WSP(bf16, WS_XB), WSP(bf16, WS_XB), (const float*)(ld_ws() + modl) + 5 * 2048, rep_ == NREP(11) - 1,
                                    WSP(bf16, WS_H), ld_in(2) + (size_t)(l + 1) * DM, (const float*)(ld_ws() + modl) + 16 * 12288 + 1 * 2048, (float*)(ld_ws() + WS_SSQ + (size_t)(2 * l + 2) * SSQ_BYTES), (LAS float*)(LDSL + 131072)};
                pg8::gemm_phase<pg8::EpiRes<true, true>, pg8::StaticOrder, true, true>(LDSL, g, S, E, otid(wave_id));
            } else {
                pg8::EpiRes<false, true> E{WSP(bf16, WS_XB), WSP(bf16, WS_XB), (const float*)(ld_ws() + modl) + 5 * 2048, rep_ == NREP(11) - 1, nullptr, nullptr, nullptr, nullptr, nullptr};
                pg8::gemm_phase<pg8::EpiRes<false, true>, pg8::StaticOrder, true, true>(LDSL, g, S, E, otid(wave_id));
            }
        } REP_END SEAM(pb + 10);
    }
    REP_BEGIN(12) if (ON(12) && IN(NPH - 1)) { Frame F = mkframe(wave_id); p_final_norm(F, ld_in(19), WSP(bf16, WS_XB), ld_out()); } REP_END
#undef IN
#undef SEAM
}

extern "C" void kernel_launch(void* const* d_in, const int* in_sizes, int n_in, void* d_out, int out_size, void* d_ws, size_t ws_size, hipStream_t stream) {
    static int grid = 0;
    if (grid == 0) {
        if (n_in != 20 || out_size != MROWS * DM || ws_size < WS_END) { fprintf(stderr, "kernel_launch: unexpected shapes (n_in %d, out %d, ws %zu)\n", n_in, out_size, ws_size); grid = -1; return; }
        int dev = 0, cus = 0, per_cu = 0;
        if (hipGetDevice(&dev) != hipSuccess || hipDeviceGetAttribute(&cus, hipDeviceAttributeMultiprocessorCount, dev) != hipSuccess) { grid = -1; return; }
        if (hipFuncSetAttribute((const void*)mk_fwd, hipFuncAttributeMaxDynamicSharedMemorySize, LDS_BYTES) != hipSuccess) { fprintf(stderr, "kernel_launch: hipFuncSetAttribute failed\n"); grid = -1; return; }
        if (hipOccupancyMaxActiveBlocksPerMultiprocessor(&per_cu, (const void*)mk_fwd, NTHREADS, LDS_BYTES) != hipSuccess || per_cu < 1) { fprintf(stderr, "kernel_launch: occupancy query says %d\n", per_cu); }
        (void)hipGetLastError();
        grid = cus;
    }
    if (grid < 0) return;
    if (hipMemsetAsync((char*)d_ws + WS_CTL, 0, CTL_ZERO_BYTES, stream) != hipSuccess) return;
    Args a{};
    for (int i = 0; i < 20; ++i) a.in[i] = (const float*)d_in[i];
    a.out = (float*)d_out; a.ws = (unsigned char*)d_ws;
#if MK_ONE_LAUNCH
    a.ph_lo = 0; a.ph_hi = NPH;
    hipLaunchKernelGGL(mk_fwd, dim3(grid), dim3(NTHREADS), LDS_BYTES, stream, a);
#else
    for (int p = 0; p < NPH; ++p) { a.ph_lo = p; a.ph_hi = p + 1; hipLaunchKernelGGL(mk_fwd, dim3(grid), dim3(NTHREADS), LDS_BYTES, stream, a); }
#endif
}
```

```cpp
#include <hip/hip_runtime.h>
#include <hip/hip_bf16.h>
#include <cstdio>
#include <cstdint>
#include <cmath>

#ifndef MK_ONE_LAUNCH
#define MK_ONE_LAUNCH 1
#endif

__device__ __forceinline__ int otid(int wave_id) { int l; asm volatile("v_mbcnt_lo_u32_b32 %0, -1, 0\n\tv_mbcnt_hi_u32_b32 %0, -1, %0" : "=v"(l)); return (wave_id << 6) | l; }
__device__ __forceinline__ float dpp_xor1(float v) { return __builtin_bit_cast(float, __builtin_amdgcn_mov_dpp(__builtin_bit_cast(int, v), 0xB1, 0xF, 0xF, true)); }
__device__ __forceinline__ float bperm(float v, int src_lane) { return __builtin_bit_cast(float, __builtin_amdgcn_ds_bpermute(src_lane << 2, __builtin_bit_cast(int, v))); }
__device__ __forceinline__ int obid() { int b = blockIdx.x; asm volatile("" : "+s"(b)); return b; }
__device__ __forceinline__ int ogrid() { int g = gridDim.x; asm volatile("" : "+s"(g)); return g; }

constexpr size_t EPI_WS_COS = 3u << 20, EPI_WS_SIN = (3u << 20) + 512 * 1024, EPI_WS_LOGF = 6u << 20, EPI_WS_G3 = 7u << 20, EPI_WS_Z = (size_t)352 << 20;
namespace pg8 {
#define PG8_LAS __attribute__((address_space(3)))
typedef unsigned short bf16_t;
typedef short bf16x8 __attribute__((ext_vector_type(8)));
typedef float f32x4 __attribute__((ext_vector_type(4)));
typedef unsigned u32x4 __attribute__((ext_vector_type(4)));
constexpr int BM = 256, BK = 64, HALF = 128, HTB = HALF * BK * 2  , STAGE_BYTES = 8 * HTB, NXCD = 8, WGM = 8;

__host__ __device__ __forceinline__ int lds_byte(int r, int c) { const int st = (r >> 4) * 2 + (c >> 5), rr = r & 15, cc = c & 31, ob = rr * 64 + cc * 2; return st * 1024 + (ob ^ (((ob >> 9) & 1) << 5)); }
__host__ __device__ __forceinline__ void stage_rc(int b, int& R, int& C) { const int st = b / 1024, sb = b % 1024, swz = sb ^ (((sb >> 9) & 1) << 5); R = (st >> 1) * 16 + swz / 64; C = (st & 1) * 32 + (swz % 64) / 2; }
__host__ __device__ __forceinline__ int perm32(int rho) { const int n = rho >> 4, i = rho & 15; return 8 * (i >> 2) + 4 * n + (i & 3); }

struct Unit { int pm, pn; };
struct Gemm { const bf16_t* A; const bf16_t* Bt; int M, N, K; };

struct StaticOrder {
    int nM, nN, nwg, G, c;
    __host__ __device__ void init(int M, int N, int G_, int c_) { nM = M / BM; nN = N / BM; nwg = nM * nN; G = G_; c = c_; }
    __host__ __device__ bool next(int i, Unit& u) const {
        const long L = (long)i * G + c; if (L >= nwg) return false;
        int wgid = (int)L; { const int q = nwg / NXCD, r = nwg % NXCD, xcd = wgid % NXCD, off = wgid / NXCD; wgid = (xcd < r ? xcd * (q + 1) : r * (q + 1) + (xcd - r) * q) + off; }
        const int nig = WGM * nN, gid = wgid / nig, fm = gid * WGM, gsz = (nM - fm) < WGM ? (nM - fm) : WGM;
        u.pm = fm + ((wgid % nig) % gsz); u.pn = (wgid % nig) / gsz; return true;
    }
    __device__ __forceinline__ void a_ready(const Unit&) const {}
    __device__ __forceinline__ void done(const Unit&) const {}
};

__device__ __forceinline__ unsigned cvt_pk_bf16(float lo, float hi) { unsigned r; asm volatile("v_cvt_pk_bf16_f32 %0, %1, %2" : "=v"(r) : "v"(lo), "v"(hi)); return r; }
typedef unsigned u32x2 __attribute__((ext_vector_type(2)));
typedef unsigned u32x4_t __attribute__((ext_vector_type(4)));
__device__ __forceinline__ float fast_sigmoid(float x) { return __builtin_amdgcn_rcpf(1.0f + __expf(-x)); }


__device__ __forceinline__ void row_rstd8(const float* ssq, const Unit& u, int wr, int fr, int fq, float (&rs)[2][4]) {
    const int lane = (fq << 4) | fr; typedef float f32x2_t __attribute__((ext_vector_type(2)));
    f32x2_t pr[2][4];
#pragma unroll
    for (int ai = 0; ai < 2; ++ai)
#pragma unroll
        for (int m = 0; m < 4; ++m) pr[ai][m] = *(const f32x2_t*)(ssq + (unsigned)((u.pm * BM + ai * HALF + wr * 64 + m * 16 + fr) * 8 + 2 * fq));
#pragma unroll
    for (int ai = 0; ai < 2; ++ai)
#pragma unroll
        for (int m = 0; m < 4; ++m) { float t = pr[ai][m].x + pr[ai][m].y; t += bperm(t, lane ^ 16); t += bperm(t, lane ^ 32); rs[ai][m] = __builtin_amdgcn_rsqf(t * (1.0f / 2048.0f) + 1e-6f); }
}

struct EpiInProj {
    static constexpr bool PERM = true, AFTER_DRAIN = false;
    __device__ __forceinline__ void prefetch(const Unit&, int, int) const {}
    unsigned char* ws; const float* ssq; const float* bias;
    __device__ __forceinline__ void operator()(const f32x4 (&acc)[2][2][4][2], const Unit& u, int wr, int wc, int fr0, int fq0) const {
        int ln_; asm volatile("v_mbcnt_lo_u32_b32 %0, -1, 0\n\tv_mbcnt_hi_u32_b32 %0, -1, %0" : "=v"(ln_)); const int fr = ln_ & 15, fq = ln_ >> 4; (void)fr0; (void)fq0;
        const int b = u.pm >> 3, t0 = (u.pm & 7) * 256;
        float rs[2][4]; row_rstd8(ssq, u, wr, fr, fq, rs);
        const float* bp = bias + (size_t)b * 5888 + u.pn * BM + wc * 32 + 8 * fq;
        bf16_t* Z = (bf16_t*)(ws + EPI_WS_Z); const float* cosT = (const float*)(ws + EPI_WS_COS); const float* sinT = (const float*)(ws + EPI_WS_SIN);
        {
            const int d1 = 16 * wc + 4 * fq;
            const int hs0 = 2 * u.pn;
            const bool rope = (hs0 >= 24 && hs0 < 34) || hs0 == 36 || hs0 == 40;
            f32x4 bz[2][2];
#pragma unroll
            for (int bj = 0; bj < 2; ++bj) { bz[bj][0] = *(const f32x4*)(bp + bj * HALF); bz[bj][1] = *(const f32x4*)(bp + bj * HALF + 4); }
            f32x4 cs[2][4], sn[2][4];
#pragma unroll
            for (int ai = 0; ai < 2; ++ai)
#pragma unroll
                for (int m = 0; m < 4; ++m) { const int t = t0 + 128 * ai + 64 * wr + 16 * m + fr; cs[ai][m] = (f32x4){1.f, 1.f, 1.f, 1.f}; sn[ai][m] = (f32x4){0.f, 0.f, 0.f, 0.f};
                    if (rope) { cs[ai][m] = *(const f32x4*)(cosT + t * 64 + d1); sn[ai][m] = *(const f32x4*)(sinT + t * 64 + d1); } }
#pragma unroll
            for (int ai = 0; ai < 2; ++ai) {
#pragma unroll
                for (int m = 0; m < 4; ++m) {
                    const int t = t0 + 128 * ai + 64 * wr + 16 * m + fr;
#pragma unroll
                    for (int bj = 0; bj < 2; ++bj) {
                        bf16_t* zp = Z + (unsigned)((((hs0 + bj) * 16 + b) * 2048 + t) * 128 + d1);
                        const f32x4 x1 = acc[ai][bj][m][0] * rs[ai][m] + bz[bj][0], x2 = acc[ai][bj][m][1] * rs[ai][m] + bz[bj][1];
                        const f32x4 y1 = x1 * cs[ai][m] - x2 * sn[ai][m], y2 = x1 * sn[ai][m] + x2 * cs[ai][m];
                        u32x2 w1, w2; w1.x = cvt_pk_bf16(y1[0], y1[1]); w1.y = cvt_pk_bf16(y1[2], y1[3]); w2.x = cvt_pk_bf16(y2[0], y2[1]); w2.y = cvt_pk_bf16(y2[2], y2[3]);
                        const auto r0 = __builtin_amdgcn_permlane16_swap(w1.x, w2.x, false, false); const auto r1 = __builtin_amdgcn_permlane16_swap(w1.y, w2.y, false, false);
                        u32x4_t wv; wv.x = r0[0]; wv.y = r1[0]; wv.z = r0[1]; wv.w = r1[1];
                        *(u32x4_t*)(zp + ((fq & 1) ? 60 : 0)) = wv;
                    }
                }
            }
        }
    }
};

template <bool NORM, bool XIN16> struct EpiRes {
    static constexpr bool PERM = true, AFTER_DRAIN = false;
    __device__ __forceinline__ void prefetch(const Unit&, int, int) const {}
    const void* xin; bf16_t* xout; const float* gate; bool st;
    bf16_t* An; const float* gn; const float* sc; float* ssq; PG8_LAS float* red;
    __device__ __forceinline__ void operator()(const f32x4 (&acc)[2][2][4][2], const Unit& u, int wr, int wc, int fr0, int fq0) const {
        int ln_; asm volatile("v_mbcnt_lo_u32_b32 %0, -1, 0\n\tv_mbcnt_hi_u32_b32 %0, -1, %0" : "=v"(ln_)); const int fr = ln_ & 15, fq = ln_ >> 4; (void)fr0; (void)fq0;
        const int b = u.pm >> 3; const int col0 = u.pn * BM + wc * 32 + 8 * fq; const int lane = (fq << 4) | fr;
        f32x4 g[2][2], gm[2][2];
#pragma unroll
        for (int bj = 0; bj < 2; ++bj)
#pragma unroll
            for (int n = 0; n < 2; ++n) { g[bj][n] = *(const f32x4*)(gate + (size_t)b * 12288 + col0 + bj * HALF + 4 * n);
                if constexpr (NORM) gm[bj][n] = *(const f32x4*)(gn + col0 + bj * HALF + 4 * n) * (*(const f32x4*)(sc + (size_t)b * 12288 + col0 + bj * HALF + 4 * n) + 1.0f); }
#pragma unroll
        for (int ai = 0; ai < 2; ++ai) {
            u32x4 xr[4][2]; f32x4 xf[4][2][2];
#pragma unroll
            for (int m = 0; m < 4; ++m) { const unsigned off = (unsigned)((u.pm * BM + ai * HALF + wr * 64 + m * 16 + fr) * 2048 + col0);
#pragma unroll
                for (int bj = 0; bj < 2; ++bj) {
                    if constexpr (XIN16) xr[m][bj] = *(const u32x4*)((const bf16_t*)xin + off + bj * HALF);
                    else { xf[m][bj][0] = *(const f32x4*)((const float*)xin + off + bj * HALF); xf[m][bj][1] = *(const f32x4*)((const float*)xin + off + bj * HALF + 4); } } }
#pragma unroll
            for (int m = 0; m < 4; ++m) { const int row = u.pm * BM + ai * HALF + wr * 64 + m * 16 + fr; const unsigned off = (unsigned)(row * 2048 + col0); float ss = 0.f;
#pragma unroll
                for (int bj = 0; bj < 2; ++bj) { f32x4 xn[2];
                    if constexpr (XIN16) { const u32x4 w = xr[m][bj];
                        xn[0] = (f32x4){__builtin_bit_cast(float, w.x << 16), __builtin_bit_cast(float, w.x & 0xffff0000u), __builtin_bit_cast(float, w.y << 16), __builtin_bit_cast(float, w.y & 0xffff0000u)};
                        xn[1] = (f32x4){__builtin_bit_cast(float, w.z << 16), __builtin_bit_cast(float, w.z & 0xffff0000u), __builtin_bit_cast(float, w.w << 16), __builtin_bit_cast(float, w.w & 0xffff0000u)}; }
                    else { xn[0] = xf[m][bj][0]; xn[1] = xf[m][bj][1]; }
#pragma unroll
                    for (int n = 0; n < 2; ++n) xn[n] = xn[n] + g[bj][n] * acc[ai][bj][m][n];
                    { u32x4 xb; xb.x = cvt_pk_bf16(xn[0][0], xn[0][1]); xb.y = cvt_pk_bf16(xn[0][2], xn[0][3]); xb.z = cvt_pk_bf16(xn[1][0], xn[1][1]); xb.w = cvt_pk_bf16(xn[1][2], xn[1][3]);
                      if (st) *(u32x4*)(xout + off + bj * HALF) = xb; else asm volatile("" :: "v"(xb)); }
                    if constexpr (NORM) { ss += ((xn[0][0] * xn[0][0] + xn[0][1] * xn[0][1]) + (xn[0][2] * xn[0][2] + xn[0][3] * xn[0][3])) + ((xn[1][0] * xn[1][0] + xn[1][1] * xn[1][1]) + (xn[1][2] * xn[1][2] + xn[1][3] * xn[1][3]));
                        const f32x4 y0 = xn[0] * gm[bj][0], y1 = xn[1] * gm[bj][1]; u32x4 w; w.x = cvt_pk_bf16(y0[0], y0[1]); w.y = cvt_pk_bf16(y0[2], y0[3]); w.z = cvt_pk_bf16(y1[0], y1[1]); w.w = cvt_pk_bf16(y1[2], y1[3]);
                        *(u32x4*)(An + off + bj * HALF) = w; } }
                if constexpr (NORM) { ss += bperm(ss, lane ^ 16); ss += bperm(ss, lane ^ 32); if (fq == 0) red[(ai * HALF + wr * 64 + m * 16 + fr) * 4 + wc] = ss; } }
        }
        if constexpr (NORM) {
            asm volatile("s_waitcnt lgkmcnt(0)" ::: "memory"); __builtin_amdgcn_s_barrier(); asm volatile("" ::: "memory");
            const int t = (wr * 4 + wc) * 64 + lane;
            if (t < 256) { const f32x4 q = *(const PG8_LAS f32x4*)(red + t * 4); ssq[(unsigned)((u.pm * BM + t) * 8 + u.pn)] = (q[0] + q[1]) + (q[2] + q[3]); }
            asm volatile("s_waitcnt lgkmcnt(0)" ::: "memory"); __builtin_amdgcn_s_barrier(); asm volatile("" ::: "memory");
        }
    }
};

struct EpiF32 {
    static constexpr bool PERM = true, AFTER_DRAIN = false;
    __device__ __forceinline__ void prefetch(const Unit&, int, int) const {}
    float* out; int ldc;
    __device__ __forceinline__ void operator()(const f32x4 (&acc)[2][2][4][2], const Unit& u, int wr, int wc, int fr0, int fq0) const {
        int ln_; asm volatile("v_mbcnt_lo_u32_b32 %0, -1, 0\n\tv_mbcnt_hi_u32_b32 %0, -1, %0" : "=v"(ln_)); const int fr = ln_ & 15, fq = ln_ >> 4; (void)fr0; (void)fq0;
        const int col0 = u.pn * BM + wc * 32 + 8 * fq;
#pragma unroll
        for (int ai = 0; ai < 2; ++ai)
#pragma unroll
            for (int m = 0; m < 4; ++m) { const size_t off = (size_t)(u.pm * BM + ai * HALF + wr * 64 + m * 16 + fr) * ldc + col0;
#pragma unroll
                for (int bj = 0; bj < 2; ++bj)
#pragma unroll
                    for (int n = 0; n < 2; ++n) *(f32x4*)(out + off + bj * HALF + 4 * n) = acc[ai][bj][m][n]; }
    }
};

struct EpiConvGate {
    static constexpr bool PERM = true, AFTER_DRAIN = false;
    bf16_t* ACT; bf16_t* SIDE; const float* cw; const float* cb; const float* ssq; const float* bias;
    PG8_LAS unsigned char* ex;
    __device__ __forceinline__ void prefetch(const Unit& u, int wid, int lane) const {
        __builtin_amdgcn_global_load_lds((const unsigned*)(ssq + (unsigned)((u.pm * BM + 32 * wid) * 8 + 4 * lane)), (PG8_LAS unsigned*)(ex + wid * 1024), 16, 0, 0);
        if (wid < 4) { const float* base = (wid < 3 ? cw + wid * 11264 : cb) + u.pn * 128 + (lane >> 5) * 5632 + (lane & 31) * 4;
            __builtin_amdgcn_global_load_lds((const unsigned*)base, (PG8_LAS unsigned*)(ex + 8192 + wid * 1024), 16, 0, 0); }
        else if (wid == 4) __builtin_amdgcn_global_load_lds((const unsigned*)(bias + (unsigned)((u.pm >> 3) * 11264 + u.pn * BM + 4 * lane)), (PG8_LAS unsigned*)(ex + 12288), 16, 0, 0);
    }
    __device__ __forceinline__ static f32x4 rotb(const f32x4 v, int src) { f32x4 r; r[0] = bperm(v[0], src); r[1] = bperm(v[1], src); r[2] = bperm(v[2], src); r[3] = bperm(v[3], src); return r; }
    __device__ __forceinline__ static void rot12(const f32x4 v, f32x4& r1, f32x4& r2) {
#pragma unroll
        for (int i = 0; i < 4; ++i) { float a, b2; const float x = v[i];
            asm volatile("s_nop 1\n\tv_mov_b32_dpp %0, %2 row_ror:1 row_mask:0xf bank_mask:0xf\n\tv_mov_b32_dpp %1, %2 row_ror:2 row_mask:0xf bank_mask:0xf" : "=&v"(a), "=&v"(b2) : "v"(x));
            r1[i] = a; r2[i] = b2; }
    }
    __device__ __forceinline__ void operator()(const f32x4 (&acc)[2][2][4][2], const Unit& u, int wr, int wc, int fr0, int fq0) const {
        int ln_; asm volatile("v_mbcnt_lo_u32_b32 %0, -1, 0\n\tv_mbcnt_hi_u32_b32 %0, -1, %0" : "=v"(ln_)); const int fr = ln_ & 15, fq = ln_ >> 4; (void)fr0; (void)fq0;
        const int lane = (fq << 4) | fr;
        float rs[2][4];
        { typedef float f32x2_t __attribute__((ext_vector_type(2)));
#pragma unroll
          for (int ai = 0; ai < 2; ++ai)
#pragma unroll
              for (int m = 0; m < 4; ++m) { const f32x2_t pr = *(const PG8_LAS f32x2_t*)(ex + ((ai * HALF + wr * 64 + m * 16 + fr) * 8 + 2 * fq) * 4);
                  float t = pr.x + pr.y; t += bperm(t, lane ^ 16); t += bperm(t, lane ^ 32); rs[ai][m] = __builtin_amdgcn_rsqf(t * (1.0f / 2048.0f) + 1e-6f); } }
        const PG8_LAS unsigned char* cwl = ex + 8192 + (wc * 32 + 4 * fq) * 4;
        const PG8_LAS unsigned char* bpl = ex + 12288 + (wc * 32 + 8 * fq) * 4;
        const int jj0 = u.pn * 128 + wc * 32 + 4 * fq;
        u32x2 wsv[2][4];
#pragma unroll
        for (int n = 0; n < 2; ++n) {
            const int jg = jj0 + 16 * n, jv = 5632 + jg;
            f32x4 w0[2], w1[2], w2[2], bc[2], bu[2];
#pragma unroll
            for (int hv = 0; hv < 2; ++hv) { const PG8_LAS unsigned char* q = cwl + hv * 512 + n * 64; w0[hv] = *(const PG8_LAS f32x4*)q; w1[hv] = *(const PG8_LAS f32x4*)(q + 1024); w2[hv] = *(const PG8_LAS f32x4*)(q + 2048); bc[hv] = *(const PG8_LAS f32x4*)(q + 3072);
                bu[hv] = *(const PG8_LAS f32x4*)(bpl + hv * 512 + n * 16); }
#pragma unroll
            for (int ai = 0; ai < 2; ++ai) {
                const int R0 = 128 * ai + 64 * wr; const int grp = (u.pm * BM + R0) >> 6;
                f32x4 pu[2];
#pragma unroll
                for (int hv = 0; hv < 2; ++hv) pu[hv] = (f32x4){0.f, 0.f, 0.f, 0.f};
#pragma unroll
                for (int m = 0; m < 4; ++m) {
                    f32x4 y[2];
#pragma unroll
                    for (int hv = 0; hv < 2; ++hv) {
                        const int jc = hv ? jv : jg;
                        const f32x4 uu = acc[ai][hv][m][n] * rs[ai][m] + bu[hv];
                        if ((m == 0 && fr < 2) || (m == 3 && fr >= 14)) { u32x2 sw; sw.x = cvt_pk_bf16(uu[0], uu[1]); sw.y = cvt_pk_bf16(uu[2], uu[3]);
                            *(u32x2*)(SIDE + (unsigned)((grp * 4 + (m == 0 ? fr : fr - 12)) * 11264 + jc)) = sw; }
                        const f32x4 wa = fr == 15 ? pu[hv] : uu, wb = fr >= 14 ? pu[hv] : uu;
                        pu[hv] = uu;
                        f32x4 yy = bc[hv] + w2[hv] * uu;
                        asm volatile("s_nop 1\n\t"
                                     "v_fmac_f32_dpp %0, %4, %12 row_ror:1 row_mask:0xf bank_mask:0xf\n\tv_fmac_f32_dpp %1, %5, %13 row_ror:1 row_mask:0xf bank_mask:0xf\n\t"
                                     "v_fmac_f32_dpp %2, %6, %14 row_ror:1 row_mask:0xf bank_mask:0xf\n\tv_fmac_f32_dpp %3, %7, %15 row_ror:1 row_mask:0xf bank_mask:0xf\n\t"
                                     "v_fmac_f32_dpp %0, %8, %16 row_ror:2 row_mask:0xf bank_mask:0xf\n\tv_fmac_f32_dpp %1, %9, %17 row_ror:2 row_mask:0xf bank_mask:0xf\n\t"
                                     "v_fmac_f32_dpp %2, %10, %18 row_ror:2 row_mask:0xf bank_mask:0xf\n\tv_fmac_f32_dpp %3, %11, %19 row_ror:2 row_mask:0xf bank_mask:0xf"
                                     : "+v"(yy[0]), "+v"(yy[1]), "+v"(yy[2]), "+v"(yy[3])
                                     : "v"(wa[0]), "v"(wa[1]), "v"(wa[2]), "v"(wa[3]), "v"(wb[0]), "v"(wb[1]), "v"(wb[2]), "v"(wb[3]),
                                       "v"(w1[hv][0]), "v"(w1[hv][1]), "v"(w1[hv][2]), "v"(w1[hv][3]), "v"(w0[hv][0]), "v"(w0[hv][1]), "v"(w0[hv][2]), "v"(w0[hv][3]));
                        y[hv] = yy;
                    }
                    f32x4 a;
#pragma unroll
                    for (int i = 0; i < 4; ++i) a[i] = y[0][i] * fast_sigmoid(y[0][i]) * y[1][i];
                    u32x2 w; w.x = cvt_pk_bf16(a[0], a[1]); w.y = cvt_pk_bf16(a[2], a[3]);
                    if (n == 0) wsv[ai][m] = w;
                    else {
                        const auto r0 = __builtin_amdgcn_permlane16_swap(wsv[ai][m].x, w.x, false, false); const auto r1 = __builtin_amdgcn_permlane16_swap(wsv[ai][m].y, w.y, false, false);
                        u32x4_t wv; wv.x = r0[0]; wv.y = r1[0]; wv.z = r0[1]; wv.w = r1[1];
                        *(u32x4_t*)(ACT + (unsigned)((u.pm * BM + R0 + 16 * m + fr) * 5632 + jj0 + ((fq & 1) ? 12 : 0))) = wv;
                    }
                }
            }
        }
    }
};

template <class Epi, class Sched, bool ALIGN_EPI = false, bool SP2 = false>
__device__ __forceinline__ void gemm_phase(PG8_LAS unsigned char* lds, const Gemm g, const Sched& S, const Epi& E, const int tid) {
    const int wid = __builtin_amdgcn_readfirstlane(tid >> 6), lane = tid & 63, wr = wid >> 2, wc = wid & 3, fr = lane & 15, fq = lane >> 4;
    const int K = g.K, nt = K / BK;
    unsigned voffA[2], voffB[2];
#pragma unroll
    for (int i = 0; i < 2; ++i) { int R, C; stage_rc(tid * 16 + i * 8192, R, C); const int Rb = Epi::PERM ? ((R & ~31) + perm32(R & 31)) : R;
        voffA[i] = (unsigned)(R * K + C) * 2u; voffB[i] = (unsigned)(Rb * K + C) * 2u; }
    const size_t kstep = (size_t)(BK * 2);
    const size_t hstep = (size_t)HALF * K * 2;
    const size_t tstep = 2 * hstep;
    const unsigned ldsw = (unsigned)wid * 1024u;
    const int aoff = lds_byte(wr * 64 + fr, fq * 8), boff = lds_byte(wc * 32 + fr, fq * 8);
#define PG8_SA(b, h) (((b) * 2 + (h)) * HTB)
#define PG8_SB(b, h) ((4 + (b) * 2 + (h)) * HTB)
#define PG8_STAGE(bufoff, gbase, voff) do { _Pragma("unroll") for (int _i = 0; _i < 2; ++_i) \
        __builtin_amdgcn_global_load_lds((const unsigned*)((const char*)(gbase) + (voff)[_i]), (PG8_LAS unsigned*)(lds + (bufoff) + ldsw + _i * 8192), 16, 0, 0); } while (0)
#define PG8_LDA(dst, b, h) do { _Pragma("unroll") for (int m = 0; m < 4; ++m) _Pragma("unroll") for (int k = 0; k < 2; ++k) dst[m][k] = *(const PG8_LAS bf16x8*)(lds + PG8_SA(b, h) + aoff + m * 2048 + k * 1024); } while (0)
#define PG8_LDB(dst, b, h) do { _Pragma("unroll") for (int n = 0; n < 2; ++n) _Pragma("unroll") for (int k = 0; k < 2; ++k) dst[n][k] = *(const PG8_LAS bf16x8*)(lds + PG8_SB(b, h) + boff + n * 2048 + k * 1024); } while (0)
#define PG8_MMA(ai, bj, At, Bt) do { __builtin_amdgcn_s_setprio(1); _Pragma("unroll") for (int m = 0; m < 4; ++m) _Pragma("unroll") for (int n = 0; n < 2; ++n) _Pragma("unroll") for (int k = 0; k < 2; ++k) \
        acc[ai][bj][m][n] = __builtin_amdgcn_mfma_f32_16x16x32_bf16(Bt[n][k], At[m][k], acc[ai][bj][m][n], 0, 0, 0); __builtin_amdgcn_s_setprio(0); } while (0)
#define PG8_WAIT_V(n) asm volatile("s_waitcnt vmcnt(" #n ")" ::: "memory")
#define PG8_WAIT_L(n) asm volatile("s_waitcnt lgkmcnt(" #n ")" ::: "memory")
#define PG8_BAR __builtin_amdgcn_s_barrier()
#define PG8_SCHED __builtin_amdgcn_sched_barrier(0)
    Unit cur, nxt; int ui = 0;
    if (!S.next(0, cur)) return;
    f32x4 acc[2][2][4][2];
#pragma unroll
    for (int a = 0; a < 2; ++a)
#pragma unroll
        for (int b = 0; b < 2; ++b)
#pragma unroll
            for (int m = 0; m < 4; ++m)
#pragma unroll
                for (int n = 0; n < 2; ++n) acc[a][b][m][n] = (f32x4){0.f, 0.f, 0.f, 0.f};
    bf16x8 At[4][2], B0[2][2], B1[2][2];
    const char* cA = (const char*)g.A + (size_t)cur.pm * tstep; const char* cB = (const char*)g.Bt + (size_t)cur.pn * tstep;
    S.a_ready(cur);
    if constexpr (SP2) {
        PG8_STAGE(PG8_SB(0, 0), cB, voffB); PG8_STAGE(PG8_SB(0, 1), cB + hstep, voffB); PG8_STAGE(PG8_SA(0, 0), cA, voffA); PG8_STAGE(PG8_SA(0, 1), cA + hstep, voffA);
        if (wr == 1) PG8_BAR;
        PG8_WAIT_V(2); PG8_BAR;
        PG8_STAGE(PG8_SB(1, 0), cB + kstep, voffB); PG8_STAGE(PG8_SA(1, 0), cA + kstep, voffA); PG8_STAGE(PG8_SB(1, 1), cB + hstep + kstep, voffB);
        PG8_WAIT_V(6); PG8_BAR;
    } else {
        PG8_STAGE(PG8_SB(0, 0), cB, voffB); PG8_STAGE(PG8_SA(0, 0), cA, voffA); PG8_STAGE(PG8_SB(0, 1), cB + hstep, voffB); PG8_STAGE(PG8_SA(0, 1), cA + hstep, voffA);
        if (wr == 1) PG8_BAR;
        PG8_WAIT_V(4); PG8_BAR;
        PG8_STAGE(PG8_SB(1, 0), cB + kstep, voffB); PG8_STAGE(PG8_SA(1, 0), cA + kstep, voffA); PG8_STAGE(PG8_SB(1, 1), cB + hstep + kstep, voffB);
        PG8_WAIT_V(6); PG8_BAR;
    }
    for (;;) {
        const bool has_next = S.next(ui + 1, nxt);
        const char* nA = has_next ? (const char*)g.A + (size_t)nxt.pm * tstep : cA; const char* nB = has_next ? (const char*)g.Bt + (size_t)nxt.pn * tstep : cB;
        for (int t = 0; t < nt; t += 2) {
            const bool last = (t == nt - 2);
            const char* a1 = cA + (size_t)(t + 1) * kstep;
            const char* a2 = last ? nA : cA + (size_t)(t + 2) * kstep; const char* b2 = last ? nB : cB + (size_t)(t + 2) * kstep;
            const char* a3 = a2 + kstep; const char* b3 = b2 + kstep;
            if (last && has_next) S.a_ready(nxt);
            if (last) E.prefetch(cur, wid, lane);
            if constexpr (SP2) {
            PG8_LDB(B0, 0, 0); PG8_LDB(B1, 0, 1); PG8_SCHED; PG8_LDA(At, 0, 0); PG8_STAGE(PG8_SA(1, 1), a1 + hstep, voffA);
            PG8_WAIT_V(8); PG8_WAIT_L(0); PG8_BAR; PG8_MMA(0, 0, At, B0); PG8_MMA(0, 1, At, B1); PG8_BAR; PG8_SCHED;
            PG8_LDA(At, 0, 1); PG8_STAGE(PG8_SB(0, 0), b2, voffB); PG8_STAGE(PG8_SB(0, 1), b2 + hstep, voffB); PG8_STAGE(PG8_SA(0, 0), a2, voffA);
            PG8_WAIT_V(8); PG8_WAIT_L(0); PG8_BAR; PG8_MMA(1, 0, At, B0); PG8_MMA(1, 1, At, B1); PG8_BAR; PG8_SCHED;
            PG8_LDB(B0, 1, 0); PG8_LDB(B1, 1, 1); PG8_SCHED; PG8_LDA(At, 1, 0); PG8_STAGE(PG8_SA(0, 1), a2 + hstep, voffA);
            PG8_WAIT_V(8); PG8_WAIT_L(0); PG8_BAR; PG8_MMA(0, 0, At, B0); PG8_MMA(0, 1, At, B1); PG8_BAR; PG8_SCHED;
            PG8_LDA(At, 1, 1); PG8_STAGE(PG8_SB(1, 0), b3, voffB); PG8_STAGE(PG8_SB(1, 1), b3 + hstep, voffB); PG8_STAGE(PG8_SA(1, 0), a3, voffA);
            PG8_WAIT_V(8); PG8_WAIT_L(0); PG8_BAR; PG8_MMA(1, 0, At, B0); PG8_MMA(1, 1, At, B1); PG8_BAR; PG8_SCHED;
            } else {
            PG8_LDB(B0, 0, 0); PG8_SCHED; PG8_LDA(At, 0, 0); PG8_STAGE(PG8_SA(1, 1), a1 + hstep, voffA);
            PG8_WAIT_L(8); PG8_BAR; PG8_WAIT_L(0); PG8_MMA(0, 0, At, B0); PG8_BAR; PG8_SCHED;
            PG8_LDB(B1, 0, 1); PG8_STAGE(PG8_SB(0, 0), b2, voffB);
            PG8_BAR; PG8_WAIT_L(0); PG8_MMA(0, 1, At, B1); PG8_BAR;
            PG8_LDA(At, 0, 1); PG8_STAGE(PG8_SA(0, 0), a2, voffA);
            PG8_BAR; PG8_WAIT_L(0); PG8_MMA(1, 0, At, B0); PG8_BAR; PG8_SCHED;
            PG8_STAGE(PG8_SB(0, 1), b2 + hstep, voffB);
            PG8_WAIT_V(6); PG8_BAR; PG8_MMA(1, 1, At, B1); PG8_BAR;
            PG8_LDB(B0, 1, 0); PG8_SCHED; PG8_LDA(At, 1, 0); PG8_STAGE(PG8_SA(0, 1), a2 + hstep, voffA);
            PG8_WAIT_L(8); PG8_BAR; PG8_WAIT_L(0); PG8_MMA(0, 0, At, B0); PG8_BAR; PG8_SCHED;
            PG8_LDB(B1, 1, 1); PG8_STAGE(PG8_SB(1, 0), b3, voffB);
            PG8_BAR; PG8_WAIT_L(0); PG8_MMA(0, 1, At, B1); PG8_BAR;
            PG8_LDA(At, 1, 1); PG8_STAGE(PG8_SA(1, 0), a3, voffA);
            PG8_BAR; PG8_WAIT_L(0); PG8_MMA(1, 0, At, B0); PG8_BAR; PG8_SCHED;
            PG8_STAGE(PG8_SB(1, 1), b3 + hstep, voffB);
            PG8_WAIT_V(6); PG8_BAR; PG8_MMA(1, 1, At, B1); PG8_BAR;
            }
        }
        if constexpr (ALIGN_EPI) { if (wr == 0) PG8_BAR; }
        if constexpr (!Epi::AFTER_DRAIN) { E(acc, cur, wr, wc, fr, fq); S.done(cur); }
        if (!has_next) break;
#pragma unroll
        for (int a = 0; a < 2; ++a)
#pragma unroll
            for (int b = 0; b < 2; ++b)
#pragma unroll
                for (int m = 0; m < 4; ++m)
#pragma unroll
                    for (int n = 0; n < 2; ++n) acc[a][b][m][n] = (f32x4){0.f, 0.f, 0.f, 0.f};
        cur = nxt; cA = nA; cB = nB; ++ui;
        if constexpr (ALIGN_EPI) { if (wr == 1) PG8_BAR; }
    }
    PG8_WAIT_V(0);
    if constexpr (!ALIGN_EPI) { if (wr == 0) PG8_BAR; }
    PG8_BAR;
    if constexpr (Epi::AFTER_DRAIN) { E.fused(acc, cur, wr, wc, fr, fq, lds, wid, lane); S.done(cur); }
#undef PG8_SA
#undef PG8_SB
#undef PG8_STAGE
#undef PG8_LDA
#undef PG8_LDB
#undef PG8_MMA
#undef PG8_WAIT_V
#undef PG8_WAIT_L
#undef PG8_BAR
#undef PG8_SCHED
}
}

namespace att {
constexpr int D = 128;
constexpr float SCALE = 0.08838834764831845f;
constexpr float THR = 8.f;
constexpr int NW = 8, QBLK = 32, KVBLK = 64, QB = NW * QBLK;
constexpr int SHM_V = KVBLK * D * 2, SHM_K = KVBLK * D * 2;
constexpr int LDS_WS = 2 * SHM_V + 2 * SHM_K, LDS_KB = LDS_WS + NW * 64 * 4, LDS_BYTES = LDS_KB + 2 * 64 * 4;
constexpr int LDO = 2048;

using bf16 = __hip_bfloat16;
typedef short bf16x8 __attribute__((ext_vector_type(8)));
typedef short s16x4 __attribute__((ext_vector_type(4)));
typedef float f32x16 __attribute__((ext_vector_type(16)));
typedef float f32x4 __attribute__((ext_vector_type(4)));
typedef unsigned u32x4 __attribute__((ext_vector_type(4)));

#define KSWZ(row, colB) ((row) * 256 + ((colB) ^ (((row) & 7) << 4)))
#define SBAR() __builtin_amdgcn_sched_barrier(0)
__device__ __forceinline__ int v_st(int k, int c) { const int kk = (k & ~0xC) | ((k & 4) << 1) | ((k & 8) >> 1); return ((kk >> 3) * 4 + (c >> 5)) * 512 + ((kk & 7) * 32 + (c & 31)) * 2; }
__device__ __forceinline__ int v_rd_base(int lane) { return ((lane & 3) << 3) | (((lane >> 2) & 3) << 6) | (((lane >> 4) & 1) << 5) | (((lane >> 5) & 1) << 8); }
constexpr int v_rd_off(int d0, int ks, int half) { return d0 * 512 + ks * 4096 + half * 2048; }
__device__ __forceinline__ int crow(int r, int hi) { return (r & 3) + 8 * (r >> 2) + 4 * hi; }
__device__ __forceinline__ unsigned cvtpk(float lo, float hi) {
    unsigned r; asm volatile("v_cvt_pk_bf16_f32 %0, %1, %2" : "=v"(r) : "v"(lo), "v"(hi)); return r;
}
__device__ __forceinline__ bf16x8 load8(const bf16* p) { return *reinterpret_cast<const bf16x8*>(p); }
__device__ __forceinline__ void mask_tile(f32x16& p0, f32x16& p1, int dq, unsigned W) {
    const float NEG = -__builtin_inff();
#pragma unroll
    for (int r = 0; r < 16; ++r) {
        const int c = (r & 3) + 8 * (r >> 2);
        if ((unsigned)(dq - c) >= W) p0[r] = NEG;
        if ((unsigned)(dq - c - 32) >= W) p1[r] = NEG;
    }
}
__device__ __forceinline__ void partialSM(f32x16& p0, f32x16& p1, float& m_reg, float& mn, float& alpha) {
    float pmax = p0[0]; for (int r = 1; r < 16; ++r) pmax = fmaxf(pmax, p0[r]); for (int r = 0; r < 16; ++r) pmax = fmaxf(pmax, p1[r]);
    { auto rr = __builtin_amdgcn_permlane32_swap(__float_as_uint(pmax), __float_as_uint(pmax), false, false);
      pmax = fmaxf(__uint_as_float(rr[0]), __uint_as_float(rr[1])); }
    constexpr float C2 = 1.4426950408889634f * SCALE;
    if (__builtin_expect(__all((pmax - m_reg) * SCALE <= THR), 1)) { mn = m_reg; alpha = 1.f; }
    else { mn = fmaxf(m_reg, pmax); alpha = __builtin_amdgcn_exp2f((m_reg - mn) * C2); m_reg = mn; }
    const float mnL = -mn * C2;
    for (int r = 0; r < 16; ++r) p0[r] = fmaf(p0[r], C2, mnL); for (int r = 0; r < 16; ++r) p1[r] = fmaf(p1[r], C2, mnL);
    for (int r = 0; r < 16; ++r) p0[r] = __builtin_amdgcn_exp2f(p0[r]);
}
#define ATT_PK4(P, B_, OUT) do { unsigned a0 = cvtpk(P[B_+0], P[B_+1]), a1 = cvtpk(P[B_+2], P[B_+3]);                          \
        unsigned b0 = cvtpk(P[B_+4], P[B_+5]), b1 = cvtpk(P[B_+6], P[B_+7]);                                             \
        auto r0 = __builtin_amdgcn_permlane32_swap(a0, b0, false, false); auto r1 = __builtin_amdgcn_permlane32_swap(a1, b1, false, false); \
        u32x4 w = {r0[0], r1[0], r0[1], r1[1]}; OUT = *reinterpret_cast<bf16x8*>(&w); } while (0)
__device__ __forceinline__ void finishSM(f32x16& p0, f32x16& p1, float alpha, float& l_reg, bf16x8& pa0, bf16x8& pa1, bf16x8& pa2, bf16x8& pa3) {
    for (int r = 0; r < 16; ++r) p1[r] = __builtin_amdgcn_exp2f(p1[r]);
    float ps = 0; for (int r = 0; r < 16; ++r) ps += p0[r]; for (int r = 0; r < 16; ++r) ps += p1[r];
    { auto rr = __builtin_amdgcn_permlane32_swap(__float_as_uint(ps), __float_as_uint(ps), false, false);
      ps = __uint_as_float(rr[0]) + __uint_as_float(rr[1]); }
    l_reg = l_reg * alpha + ps;
    ATT_PK4(p0, 0, pa0); ATT_PK4(p0, 8, pa1); ATT_PK4(p1, 0, pa2); ATT_PK4(p1, 8, pa3);
}
template <int KB, bool SK, int INIT = 0>
__device__ __forceinline__ void qkt(f32x16& p0, f32x16& p1, const char* K_lds, int r32, int hi, const bf16x8* qr, bool act, const float* kbias = nullptr, float iv = 0.f) {
    if (SK && !act) { const float NEG = -__builtin_inff();
#pragma unroll
        for (int r = 0; r < 16; ++r) { p0[r] = NEG; p1[r] = NEG; } return; }
    if constexpr (INIT == 1) { const float* kq_ = kbias + KB * 64 + 4 * hi;
#pragma unroll
        for (int a_ = 0; a_ < 4; ++a_) { const f32x4 b0_ = *(const f32x4*)(kq_ + 8 * a_), b1_ = *(const f32x4*)(kq_ + 32 + 8 * a_);
#pragma unroll
            for (int i_ = 0; i_ < 4; ++i_) { p0[4 * a_ + i_] = b0_[i_]; p1[4 * a_ + i_] = b1_[i_]; } } }
    else if constexpr (INIT == 2) {
#pragma unroll
        for (int r = 0; r < 16; ++r) { p0[r] = iv; p1[r] = iv; } }
    else { p0 = f32x16{}; p1 = f32x16{}; }
    const char* kb[4];
#pragma unroll
    for (int dd = 0; dd < 4; ++dd) kb[dd] = K_lds + KB * SHM_K + KSWZ(r32, (dd * 16 + hi * 8) * 2);
#pragma unroll
    for (int d0 = 0; d0 < 8; ++d0) { const char* a = kb[d0 & 3] + (d0 >> 2) * 128;
        bf16x8 b0 = *reinterpret_cast<const bf16x8*>(a);
        bf16x8 b1 = *reinterpret_cast<const bf16x8*>(a + 32 * 256);
        p0 = __builtin_amdgcn_mfma_f32_32x32x16_bf16(b0, qr[d0], p0, 0, 0, 0);
        p1 = __builtin_amdgcn_mfma_f32_32x32x16_bf16(b1, qr[d0], p1, 0, 0, 0); }
}
template <int VB, bool SK>
__device__ __forceinline__ void pv_tile(f32x16* o, int vb0, bf16x8 pa0, bf16x8 pa1, bf16x8 pa2, bf16x8 pa3, bool act) {
    if (SK && !act) return;
#define TRRD(dst, off) asm volatile("ds_read_b64_tr_b16 %0, %1 offset:%2" : "=&v"(dst) : "v"(vb0), "i"(off) : "memory")
#define PV_D0(d0) do { s16x4 l0, l1, l2, l3, h0, h1, h2, h3; constexpr int b_ = VB * SHM_V + v_rd_off(d0, 0, 0);     \
        TRRD(l0, b_); TRRD(h0, b_ + 2048); TRRD(l1, b_ + 4096); TRRD(h1, b_ + 6144); TRRD(l2, b_ + 8192); TRRD(h2, b_ + 10240); TRRD(l3, b_ + 12288); TRRD(h3, b_ + 14336); \
        asm volatile("s_waitcnt lgkmcnt(0)" ::: "memory"); SBAR();                 \
        o[d0] = __builtin_amdgcn_mfma_f32_32x32x16_bf16(pa0, (bf16x8){l0[0], l0[1], l0[2], l0[3], h0[0], h0[1], h0[2], h0[3]}, o[d0], 0, 0, 0);   \
        o[d0] = __builtin_amdgcn_mfma_f32_32x32x16_bf16(pa1, (bf16x8){l1[0], l1[1], l1[2], l1[3], h1[0], h1[1], h1[2], h1[3]}, o[d0], 0, 0, 0);   \
        o[d0] = __builtin_amdgcn_mfma_f32_32x32x16_bf16(pa2, (bf16x8){l2[0], l2[1], l2[2], l2[3], h2[0], h2[1], h2[2], h2[3]}, o[d0], 0, 0, 0);   \
        o[d0] = __builtin_amdgcn_mfma_f32_32x32x16_bf16(pa3, (bf16x8){l3[0], l3[1], l3[2], l3[3], h3[0], h3[1], h3[2], h3[3]}, o[d0], 0, 0, 0); } while (0)
    PV_D0(0); PV_D0(1); PV_D0(2); PV_D0(3);
#undef PV_D0
#undef TRRD
}

struct BlockRef { unsigned q, k, v, o, x, s; int P0; };
struct Bases { const bf16* Zb; bf16* Ob; const float* Xf; const unsigned* Sel; bool st; };
struct Seam {
    bf16x8 qr[8];
    bf16x8 st_v0, st_v1, st_k0, st_k1; float st_b;
};
__device__ __forceinline__ int swa_jlo(int P0, int W) { const int lowk = P0 - W + 1; return lowk > 0 ? lowk / KVBLK : 0; }
#define ROW(p, k0, rr) ((p) + (size_t)((k0) + (rr)) * D + sc)
#define VMW() asm volatile("s_waitcnt vmcnt(0)" ::: "memory")
#define VMWN(n) asm volatile("s_waitcnt vmcnt(%0)" :: "i"(n) : "memory")
#define SLOAD_H(Kp, Vp, Bp, k0) do { S.st_v0 = load8(ROW(Vp, k0, sr)); S.st_v1 = load8(ROW(Vp, k0, 32 + sr));              \
                         S.st_k0 = load8(ROW(Kp, k0, sr)); S.st_k1 = load8(ROW(Kp, k0, 32 + sr)); if constexpr (MODE == 0 && !(VAR & 1)) { if (wid == 0) S.st_b = (Bp)[(k0) + lane]; } } while (0)
#define SWRITE_HK(bf) do { *(bf16x8*)(K_lds + (bf) * SHM_K + kws) = S.st_k0; *(bf16x8*)(K_lds + (bf) * SHM_K + kws + 32 * 256) = S.st_k1; \
                         if constexpr (MODE == 0 && !(VAR & 1)) { if (wid == 0) kb_l[(bf) * 64 + lane] = S.st_b; } } while (0)
#define SWRITE_HV(bf) do { *(bf16x8*)(V_lds + (bf) * SHM_V + vst0) = S.st_v0; *(bf16x8*)(V_lds + (bf) * SHM_V + vst1) = S.st_v1; } while (0)
#define SWRITE_H(bf) do { SWRITE_HV(bf); SWRITE_HK(bf); } while (0)
template <int MODE, int VAR = 0>
__device__ __forceinline__ void att_prime(const Bases& BS, const BlockRef& cur, char* lds, Seam& S, const int tid) {
    constexpr int W = (MODE == 1) ? 512 : (1 << 30);
    const int wid = __builtin_amdgcn_readfirstlane(tid >> 6), lane = tid & 63, r32 = lane & 31, hi = lane >> 5;
    const int sr = tid >> 4, sc = (tid & 15) * 8, kws = KSWZ(sr, sc * 2); char* K_lds = lds + 2 * SHM_V; float* kb_l = (float*)(lds + LDS_KB);
    const int kb0 = swa_jlo(cur.P0, W) * KVBLK;
    for (int d0 = 0; d0 < 8; ++d0) S.qr[d0] = load8(BS.Zb + cur.q + (size_t)(wid * QBLK + r32) * D + d0 * 16 + hi * 8);
    SLOAD_H(BS.Zb + cur.k, BS.Zb + cur.v, BS.Xf + cur.x, kb0); VMW(); SWRITE_HK(0);
    __syncthreads();
}
template <int MODE, int VAR = 0>
__device__ __forceinline__ void att_block(const Bases& BS, const BlockRef& cur, const BlockRef& nxt, int skv, char* lds, Seam& S, const int tid) {
    constexpr int W = (MODE == 1) ? 512 : (1 << 30);
    constexpr bool SK = (MODE == 1);
    const int wid = __builtin_amdgcn_readfirstlane(tid >> 6), lane = tid & 63, r32 = lane & 31, hi = lane >> 5;
    const int j_lo = swa_jlo(cur.P0, W);
    int j_hi = (cur.P0 + QB - 1) / KVBLK + 1; if (j_hi > skv / KVBLK) j_hi = skv / KVBLK;
    const int NT = j_hi - j_lo;
    const int kbn = swa_jlo(nxt.P0, W) * KVBLK;
    const int qlo = cur.P0 + wid * QBLK, qm = qlo + r32 - 4 * hi;
    char* V_lds = lds; char* K_lds = lds + 2 * SHM_V;
    float* ws = (float*)(lds + LDS_WS) + wid * 64; float* li_l = ws, * al_l = ws + 32; float* kb_l = (float*)(lds + LDS_KB);
    float m_reg = -1e30f, l_reg = 0; f32x16 o[4] = {};
    const int sr = tid >> 4, sc = (tid & 15) * 8, vst0 = v_st(sr, sc), vst1 = v_st(32 + sr, sc), kws = KSWZ(sr, sc * 2);
    const int vb0 = (int)(uintptr_t)V_lds + v_rd_base(lane);
    const bf16* Kh = BS.Zb + cur.k; const bf16* Vh = BS.Zb + cur.v; const float* Bh = BS.Xf + cur.x;
    unsigned selw = 0xffffffffu; if constexpr (MODE == 2) selw = BS.Sel[cur.s + qlo + r32];
#define RESC(a) do { if (__any((a) < 1.f)) { if (hi == 0) al_l[r32] = (a); asm volatile("s_waitcnt lgkmcnt(0)" ::: "memory");              \
                     for (int d_ = 0; d_ < 4; ++d_) for (int r = 0; r < 16; ++r) o[d_][r] *= al_l[crow(r, hi)]; } } while (0)
#define KBASE(t) ((j_lo + (t)) * KVBLK)
#define ACT(t) (KBASE(t) <= qlo + QBLK - 1 && KBASE(t) + KVBLK - 1 >= qlo - W + 1)
#define SELIV(t) ((MODE == 2) ? ((((selw >> (j_lo + (t))) & 1u) != 0u) ? 0.f : -__builtin_inff()) : 0.f)
#define QKT(KB_, P0_, P1_, t) qkt<KB_, SK, ((MODE == 0 && !(VAR & 1)) ? 1 : (MODE == 2 ? 2 : 0))>(P0_, P1_, K_lds, r32, hi, S.qr, ACT(t), kb_l, SELIV(t))
#define MASKT(P0_, P1_, t, KBUF) do { const int kb_ = KBASE(t); if ((!SK || ACT(t)) && (kb_ + KVBLK - 1 > qlo || kb_ <= qlo + QBLK - 1 - W)) mask_tile(P0_, P1_, qm - kb_, (unsigned)W); } while (0)
    constexpr int NQL = 8;
#define SEAM_K0() do { VMWN(NQL); SWRITE_HK(0); SBAR(); } while (0)
    f32x16 pA0, pA1, pB0, pB1; float mnA, mnB, alA, alB; bf16x8 pa0, pa1, pa2, pa3;
    SWRITE_HV(0); SBAR();
    if (NT > 1) { SLOAD_H(Kh, Vh, Bh, KBASE(1)); }
    SBAR(); QKT(0, pA0, pA1, 0);
    MASKT(pA0, pA1, 0, 0); partialSM(pA0, pA1, m_reg, mnA, alA);
    if (NT > 1) { VMW(); SWRITE_H(1); }
    __syncthreads();
#define HALF_STEP(PX0, PX1, mnX, alX, PY0, PY1, alY, t, KB, VB, SB) do {                                                      \
        if ((t) + 1 < NT) { SLOAD_H(Kh, Vh, Bh, KBASE((t) + 1)); SBAR(); }     \
        SBAR(); QKT(KB, PX0, PX1, t);                                             \
        finishSM(PY0, PY1, alY, l_reg, pa0, pa1, pa2, pa3); SBAR();                                                           \
        pv_tile<VB, SK>(o, vb0, pa0, pa1, pa2, pa3, ACT((t) - 1)); MASKT(PX0, PX1, (t), KB); partialSM(PX0, PX1, m_reg, mnX, alX);                                        \
        __syncthreads();                                                                                                      \
        if ((t) + 1 < NT) { VMW(); SWRITE_H(SB); }                                                                          \
        RESC(alX); __syncthreads(); } while (0)
    for (int t = 1; t + 1 < NT; t += 2) {
        HALF_STEP(pB0, pB1, mnB, alB, pA0, pA1, alA, t, 1, 0, 0);
        HALF_STEP(pA0, pA1, mnA, alA, pB0, pB1, alB, t + 1, 0, 1, 1);
    }
    const bool even = (NT & 1) == 0;
    if (even) { SBAR(); QKT(1, pB0, pB1, NT - 1); SBAR(); }
    float gq = 1.f; if constexpr (MODE != 0) gq = BS.Xf[cur.x + qlo + r32];
    SLOAD_H(BS.Zb + nxt.k, BS.Zb + nxt.v, BS.Xf + nxt.x, kbn); SBAR();
#pragma unroll
    for (int d0 = 0; d0 < 8; ++d0) S.qr[d0] = load8(BS.Zb + nxt.q + (size_t)(wid * QBLK + r32) * D + d0 * 16 + hi * 8);
    SBAR();
    finishSM(pA0, pA1, alA, l_reg, pa0, pa1, pa2, pa3); SBAR();
    pv_tile<0, SK>(o, vb0, pa0, pa1, pa2, pa3, ACT(even ? NT - 2 : NT - 1));
    if (even) { MASKT(pB0, pB1, NT - 1, 1); partialSM(pB0, pB1, m_reg, mnB, alB); __syncthreads(); RESC(alB);
        finishSM(pB0, pB1, alB, l_reg, pa0, pa1, pa2, pa3); SBAR(); pv_tile<1, SK>(o, vb0, pa0, pa1, pa2, pa3, ACT(NT - 1)); }
    SBAR(); SEAM_K0();
    if (hi == 0) li_l[r32] = gq / l_reg; asm volatile("s_waitcnt lgkmcnt(0)" ::: "memory");
    float rli[16];
#pragma unroll
    for (int r = 0; r < 16; ++r) rli[r] = li_l[crow(r, hi)];
    int hi_e = hi, r32_e = r32; asm volatile("" : "+v"(hi_e), "+v"(r32_e));
    {
        char* stg = lds + 73728 + wid * 8704;
        char* wp = stg + (4 * hi_e) * 272 + r32_e * 2;
        const int le = hi_e * 32 + r32_e, rrow = le >> 4, cb = (le & 15) * 16;
        bf16* Og = BS.Ob + cur.o + (size_t)(wid * QBLK + rrow) * LDO + (cb >> 1);
        u32x4 sv[8], old[8];
        if constexpr (MODE == 2) {
#pragma unroll
            for (int j = 0; j < 8; ++j) old[j] = *(const u32x4*)(Og + (size_t)(4 * j) * LDO);
        }
#pragma unroll
        for (int d0 = 0; d0 < 4; ++d0) {
            float v16[16], n16[16];
#pragma unroll
            for (int r = 0; r < 16; ++r) { v16[r] = o[d0][r] * rli[r]; n16[r] = dpp_xor1(v16[r]); }
            if ((r32 & 1) == 0) {
#pragma unroll
                for (int r = 0; r < 16; ++r) *(unsigned*)(wp + crow(r, 0) * 272 + d0 * 64) = cvtpk(v16[r], n16[r]);
            }
        }
        asm volatile("s_waitcnt lgkmcnt(0)" ::: "memory");
        const char* rp = stg + rrow * 272 + cb;
#pragma unroll
        for (int j = 0; j < 8; ++j) sv[j] = *(const u32x4*)(rp + (4 * j) * 272);
#pragma unroll
        for (int j = 0; j < 8; ++j) {
            u32x4 w = sv[j];
            if constexpr (MODE == 2) {
#pragma unroll
                for (int e = 0; e < 4; ++e) w[e] = cvtpk(__uint_as_float(sv[j][e] << 16) + __uint_as_float(old[j][e] << 16), __uint_as_float(sv[j][e] & 0xffff0000u) + __uint_as_float(old[j][e] & 0xffff0000u));
            }
            if (BS.st) *(u32x4*)(Og + (size_t)(4 * j) * LDO) = w; else asm volatile("" :: "v"(w));
        }
    }
    __syncthreads();
#undef RESC
#undef KBASE
#undef ACT
#undef SELIV
#undef QKT
#undef MASKT
#undef SEAM_K0
#undef HALF_STEP
}
#undef ROW
#undef VMW
#undef VMWN
#undef SLOAD_H
#undef SWRITE_HK
#undef SWRITE_HV
#undef SWRITE_H
}

using att::crow; using att::cvtpk; typedef att::u32x4 u32x4;

constexpr int NWAVES = 8, NTHREADS = 512;
constexpr int BATCH = 16, SEQ = 2048, DM = 2048, MROWS = BATCH * SEQ, DFF = 5632, NUP = 2 * DFF, DIN = 5664, NINP = 5888, DEPTH = 2;
constexpr float RMS_EPS = 1e-6f;
constexpr size_t MiB = 1u << 20;
constexpr size_t WS_CTL = 0, CTL_ZERO_BYTES = 64 * 1024;
constexpr size_t WS_MOD = 1 * MiB;
constexpr size_t WS_COS = 3 * MiB, WS_SIN = 3 * MiB + 512 * 1024;
constexpr size_t WS_POSB = 4 * MiB;
constexpr size_t WS_KBIAS = 5 * MiB;
constexpr size_t WS_LOGF = 6 * MiB;
constexpr size_t WS_G3 = 7 * MiB;
constexpr size_t WS_SELM = 10 * MiB;
constexpr size_t WS_KCMP = 11 * MiB, WS_VCMPT = 12 * MiB;
constexpr size_t WS_T1 = 13 * MiB;
constexpr size_t WS_W = 24 * MiB;
constexpr size_t W_IN = 0, W_OUT = 23 * MiB, W_UP = 31 * MiB, W_DOWN = 75 * MiB, W_C1 = 97 * MiB, W_LAYER = 99 * MiB;
constexpr size_t WS_H = 224 * MiB;
constexpr size_t WS_Z = 352 * MiB;
constexpr size_t WS_O = 704 * MiB;
constexpr size_t WS_ACT = WS_Z;
constexpr size_t WS_SIDE = 832 * MiB;
constexpr size_t WS_SSQ = 876 * MiB;
constexpr size_t SSQ_BYTES = (size_t)32768 * 8 * 4;
constexpr size_t WS_BIAS = 21 * MiB;
constexpr size_t BIAS_UP_OFF = (size_t)2 * 16 * 5888 * 4;
constexpr size_t WS_XB = 880 * MiB;
constexpr size_t WS_END = 1008 * MiB;
static_assert(WS_W + 2 * W_LAYER <= WS_H && WS_H + 128 * MiB <= WS_Z && WS_Z + 352 * MiB <= WS_O && WS_O + 128 * MiB <= WS_SIDE && WS_SIDE + 44 * MiB <= WS_SSQ && WS_SSQ + 4 * SSQ_BYTES <= WS_XB && WS_XB + 128 * MiB <= WS_END && WS_BIAS + BIAS_UP_OFF + (size_t)2 * 16 * 11264 * 4 <= WS_W && WS_T1 + 8 * MiB <= WS_BIAS, "ws map");
constexpr int CW_BAR = 1024;
constexpr int SCR_BYTES = 148 * 1024;
constexpr int MISC_OFF = SCR_BYTES;
constexpr int LDS_BYTES = 159744;

#define GAS __attribute__((address_space(1)))
#define LAS __attribute__((address_space(3)))
typedef unsigned short bf16;
typedef unsigned v4u __attribute__((ext_vector_type(4)));
typedef unsigned v2u __attribute__((ext_vector_type(2)));
typedef float f32x4 __attribute__((ext_vector_type(4)));
typedef float f32x2 __attribute__((ext_vector_type(2)));
typedef float f32x16 __attribute__((ext_vector_type(16)));
typedef short bf16x8 __attribute__((ext_vector_type(8)));
#define LDS_WAIT() asm volatile("s_waitcnt lgkmcnt(0)" ::: "memory")
#define VM_WAIT() asm volatile("s_waitcnt vmcnt(0)" ::: "memory")
__device__ __forceinline__ unsigned f2bf(float f) { unsigned u = __builtin_bit_cast(unsigned, f); return (u + 0x7fffu + ((u >> 16) & 1u)) >> 16; }
__device__ __forceinline__ unsigned pk2(float lo, float hi) { return f2bf(lo) | (f2bf(hi) << 16); }
__device__ __forceinline__ float bf2f(unsigned short h) { return __builtin_bit_cast(float, (unsigned)h << 16); }

static_assert(EPI_WS_COS == WS_COS && EPI_WS_SIN == WS_SIN && EPI_WS_LOGF == WS_LOGF && EPI_WS_G3 == WS_G3 && EPI_WS_Z == WS_Z, "epilogue offsets");
#define XB_TMO      128
#define XB_XCNT(j)  (256  + 64 * (j))
#define XB_XSUB(j)  (1280 + 64 * (j))
#define XB_XGEN(j)  (2304 + 64 * (j))
#define XB_TOP      3328
#define XB_TOPGEN   3392
#define XCD_BAR_WORDS 3456
#define XB_SPIN_CAP (1u << 18)

__device__ __forceinline__ unsigned xb_ld(unsigned* p)              { return __hip_atomic_load(p, __ATOMIC_RELAXED, __HIP_MEMORY_SCOPE_AGENT); }
__device__ __forceinline__ unsigned xb_add(unsigned* p, unsigned v) { return __hip_atomic_fetch_add(p, v, __ATOMIC_RELAXED, __HIP_MEMORY_SCOPE_AGENT); }
__device__ __forceinline__ unsigned xb_xcc_id() { return (unsigned)__builtin_amdgcn_s_getreg((3 << 11) | 20) & 0xFu; }
#define XB_SPIN(cond, bar) do { unsigned _sp = 0; while (cond) { __builtin_amdgcn_s_sleep(1); \
    if ((++_sp & 255u) == 0u) { if (xb_ld(&(bar)[XB_TMO])) break; if (_sp > XB_SPIN_CAP) { atomicAdd(&(bar)[XB_TMO], 1u); break; } } } } while (0)

struct XcdBarrier {
    unsigned* bar; unsigned x;
    volatile LAS unsigned* st;
};

__device__ __forceinline__ XcdBarrier xcd_barrier_post(unsigned* bar, volatile LAS unsigned* st) {
    XcdBarrier b; b.bar = bar; b.x = xb_xcc_id(); b.st = st;
    if (threadIdx.x == 0) (void)xb_add(&bar[XB_XCNT(b.x)], 1u);
    return b;
}
__device__ __forceinline__ void xcd_barrier_complete(unsigned* bar, unsigned x, unsigned& nloc, unsigned& nx) {
    const unsigned G = gridDim.x * gridDim.y * gridDim.z;
    unsigned sum, cnt, mine, sp = 0u;
    for (;;) {
        sum = 0u; cnt = 0u; mine = 0u;
        unsigned xo = x; asm volatile("" : "+s"(xo));
#pragma unroll
        for (unsigned j = 0; j < 16; ++j) { const unsigned c = xb_ld(&bar[XB_XCNT(j)]); sum += c; cnt += (c > 0u) ? 1u : 0u; mine = (j == xo) ? c : mine; }
        if (sum == G) break;
        __builtin_amdgcn_s_sleep(1);
        if ((++sp & 255u) == 0u) { if (xb_ld(&bar[XB_TMO])) break; if (sp > XB_SPIN_CAP) { atomicAdd(&bar[XB_TMO], 1u); break; } }
    }
    nloc = mine > 0u ? mine : 1u; nx = cnt > 0u ? cnt : 1u;
}

__device__ __forceinline__ void xcd_barrier(const XcdBarrier& b, const bool thread0  ) {
    asm volatile("s_waitcnt vmcnt(0)" ::: "memory");
    __syncthreads();
    if (thread0) {
        unsigned* bar = b.bar;
        __builtin_amdgcn_s_waitcnt(0);
        unsigned nloc = b.st[0], nx = b.st[1];
        if (nloc == 0u) { xcd_barrier_complete(bar, b.x, nloc, nx); b.st[0] = nloc; b.st[1] = nx; }
        const unsigned old = xb_add(&bar[XB_XSUB(b.x)], 1u);
        const unsigned gen = old / nloc;
        if (old + 1u == (gen + 1u) * nloc) {
            __builtin_amdgcn_fence(__ATOMIC_RELEASE, "agent");
            asm volatile("s_waitcnt vmcnt(0)" ::: "memory");
            const unsigned og = xb_add(&bar[XB_TOP], 1u);
            const unsigned tg = og / nx;
            if (og + 1u == (tg + 1u) * nx) xb_add(&bar[XB_TOPGEN], 1u);
            else XB_SPIN(xb_ld(&bar[XB_TOPGEN]) == tg, bar);
            __builtin_amdgcn_fence(__ATOMIC_ACQUIRE, "agent");
            xb_add(&bar[XB_XGEN(b.x)], 1u);
            asm volatile("s_waitcnt vmcnt(0)" ::: "memory");
        } else {
            XB_SPIN(xb_ld(&bar[XB_XGEN(b.x)]) == gen, bar);
            __builtin_amdgcn_fence(__ATOMIC_ACQUIRE, "agent");
            asm volatile("s_waitcnt vmcnt(0)" ::: "memory");
        }
    }
    __syncthreads();
}


extern __shared__ __attribute__((aligned(16))) unsigned char g_lds[];
#define LDSL ((LAS unsigned char*)g_lds)
struct Frame { int vcu, G, bx, wave_id; };
__device__ __forceinline__ Frame mkframe(int wave_id) { Frame F; F.wave_id = wave_id; F.G = ogrid(); F.bx = obid(); F.vcu = (F.G % 8 == 0) ? (F.bx % 8) * (F.G / 8) + F.bx / 8 : F.bx; return F; }
#define PH_IDS() const int tid = otid(F.wave_id), lane = tid & 63, wave = F.wave_id; (void)lane; (void)wave
typedef const float* cfp_t;
struct Args { const float* in[20]; float* out; unsigned char* ws; int ph_lo, ph_hi; };
__device__ __forceinline__ unsigned opaque0() { unsigned z = 0; asm volatile("" : "+s"(z)); return z; }
__device__ __forceinline__ const float* ld_in(int i) { const __attribute__((address_space(4))) cfp_t* ka = (const __attribute__((address_space(4))) cfp_t*)__builtin_amdgcn_kernarg_segment_ptr(); return ka[i + opaque0()]; }
__device__ __forceinline__ float* ld_out() { return (float*)ld_in(20); }
__device__ __forceinline__ unsigned char* ld_ws() { return (unsigned char*)ld_in(21); }
#define WSP(T, off) ((T*)(ld_ws() + (off)))
__device__ __forceinline__ bf16* wl(int l, size_t off) { return (bf16*)(ld_ws() + WS_W + (size_t)l * W_LAYER + off); }
__device__ __forceinline__ unsigned zoff(int s, int b) { return (unsigned)((s * 16 + b) * 2048) * 128u; }
struct WQ { unsigned* base; int per_shard, shard, tried; };
__device__ __forceinline__ int wq_next(WQ& q, int lane) {
    while (q.tried < 8) {
        unsigned t = 0u; if (lane == 0) t = __hip_atomic_fetch_add(q.base + 64 * q.shard, 1u, __ATOMIC_RELAXED, __HIP_MEMORY_SCOPE_AGENT);
        const int ti = __builtin_amdgcn_readfirstlane((int)t);
        if (ti < q.per_shard) return ti * 8 + q.shard;
        q.shard = (q.shard + 1) & 7; ++q.tried;
    }
    return -1;
}
constexpr size_t CTL_WQ_COPY = 49152, CTL_WQ_NORM = 51200;
__device__ __forceinline__ float wave_sum(float v, int lane) {
#pragma unroll
    for (int o = 1; o < 64; o <<= 1) v += bperm(v, lane ^ o);
    return v;
}

__device__ __forceinline__ int win_src_col(int r) {
    const int pn = r >> 8, p = r & 255;
    if (pn < 22) { const int hs = 2 * pn + (p >> 7), pp = p & 127; const int d = 16 * (pp >> 5) + 4 * ((pp & 31) >> 3) + (pp & 3) + 64 * ((pp & 7) >> 2);
        return (hs < 24 ? hs * 128 : 3080 + (hs - 24) * 128) + d; }
    if (p < 8) return 3072 + p;
    if (p < 32) return 5640 + (p - 8);
    return -1;
}
__device__ __forceinline__ int wup_src_col(int r) { const int pn = r >> 8, p = r & 255, pp = p & 127; const int ch = (pp & ~31) | (((pp >> 2) & 1) << 4) | (((pp >> 3) & 3) << 2) | (pp & 3); return ((p >> 7) ? DFF : 0) + pn * 128 + ch; }
template <int MAP  >
__device__ __forceinline__ void p0_transpose_item(const float* W, int K, int ldw, int nblk, bf16* WT, int row_off, LAS float* scr, int item, int lane) {
    const int kb = item / nblk, nb = item % nblk, k0 = 64 * kb, n0 = 64 * nb;
    const int kr = lane >> 4, q = lane & 15, nrow = n0 + 4 * q;
    const int src = MAP == 0 ? nrow : (MAP == 1 ? win_src_col(nrow) : wup_src_col(nrow));
    f32x4 tv[16];
#pragma unroll
    for (int i = 0; i < 16; ++i) tv[i] = src >= 0 ? *(const f32x4*)(W + (size_t)(k0 + 4 * i + kr) * ldw + src) : (f32x4){0.f, 0.f, 0.f, 0.f};
#pragma unroll
    for (int i = 0; i < 16; ++i) { LAS float* d = scr + (4 * i + kr) * 65 + 4 * q; d[0] = tv[i].x; d[1] = tv[i].y; d[2] = tv[i].z; d[3] = tv[i].w; }
    LDS_WAIT(); asm volatile("" ::: "memory");
    const int c = lane & 7;
#pragma unroll
    for (int j = 0; j < 8; ++j) { const int n = (lane >> 3) + 8 * j; const LAS float* sp = scr + (8 * c) * 65 + n;
        v4u o; o.x = pk2(sp[0 * 65], sp[1 * 65]); o.y = pk2(sp[2 * 65], sp[3 * 65]); o.z = pk2(sp[4 * 65], sp[5 * 65]); o.w = pk2(sp[6 * 65], sp[7 * 65]);
        *(GAS v4u*)(WT + (size_t)(row_off + n0 + n) * K + k0 + 8 * c) = o; }
    LDS_WAIT(); asm volatile("" ::: "memory");
}
__device__ __forceinline__ void p0_prologue(Frame& F) {
    PH_IDS();
    const int blk = F.vcu;
    if (blk < 192) {
        const int l = blk / 96, n0 = (blk % 96) * 128;
        LAS float* ca = (LAS float*)LDSL;
        const float* c = ld_in(1);
        for (int i = tid; i < 16 * 2048; i += NTHREADS) { const int b = i >> 11, k = i & 2047; const float v = c[i]; ca[k * 16 + b] = v / (1.f + expf(-v)); }
        __syncthreads();
        const int hl = lane >> 5, cl = lane & 31;
        const float* W = ld_in(4) + (size_t)l * 2048 * 12288 + n0 + 4 * cl;
        f32x4 acc[16];
#pragma unroll
        for (int b = 0; b < 16; ++b) acc[b] = (f32x4){0.f, 0.f, 0.f, 0.f};
        const int kbeg = wave * 256 + hl;
#pragma unroll 8
        for (int i = 0; i < 128; ++i) {
            const int k = kbeg + 2 * i;
            const f32x4 w = *(const f32x4*)(W + (size_t)k * 12288);
            const LAS f32x4* cp = (const LAS f32x4*)(ca + k * 16);
            const f32x4 c0 = cp[0], c1 = cp[1], c2 = cp[2], c3 = cp[3];
#pragma unroll
            for (int j = 0; j < 4; ++j) { acc[j] += w * c0[j]; acc[4 + j] += w * c1[j]; acc[8 + j] += w * c2[j]; acc[12 + j] += w * c3[j]; }
        }
        __syncthreads();
        LAS float* part = (LAS float*)LDSL;
#pragma unroll
        for (int b = 0; b < 16; ++b) *(LAS f32x4*)(part + ((wave * 2 + hl) * 16 + b) * 128 + 4 * cl) = acc[b];
        __syncthreads();
        const int tid2 = otid(F.wave_id);
        for (int i = tid2; i < 16 * 128; i += NTHREADS) { const int b = i >> 7, n = i & 127; float s = 0.f;
#pragma unroll
            for (int w = 0; w < 16; ++w) s += part[(w * 16 + b) * 128 + n];
            WSP(float, WS_MOD)[((size_t)l * 16 + b) * 12288 + n0 + n] = s + ld_in(5)[(size_t)l * 12288 + n0 + n]; }
        __syncthreads();
    }
    for (int i = blk * NTHREADS + otid(F.wave_id); i < 2048 * 64; i += F.G * NTHREADS) { const int t = i >> 6, j = i & 63;
        const float inv = powf(10000.0f, -(float)(2 * j) / 128.0f); const float ang = (float)t * inv; WSP(float, WS_COS)[i] = cosf(ang); WSP(float, WS_SIN)[i] = sinf(ang); }
    { const int tidc = otid(F.wave_id); const int q = tidc >> 7, j = tidc & 127, l = q >> 1, kv = q & 1;
      for (int bb = blk; bb < 256; bb += F.G) {
          const float* pos = ld_in(8 + kv) + (size_t)l * 4096 + 16 * bb; const float* w1 = ld_in(10 + 2 * kv) + (size_t)l * 4096 * 128 + (size_t)(16 * bb) * 128 + j;
          float sacc = 0.f;
#pragma unroll
          for (int r = 0; r < 16; ++r) sacc += pos[r] * w1[(size_t)r * 128];
          WSP(float, WS_POSB)[(size_t)bb * 512 + tidc] = sacc; } }
    const int lane_d = otid(F.wave_id) & 63;
    LAS float* scr = (LAS float*)(LDSL + wave * 16896);
    const int gw = F.vcu * NWAVES + wave, NGW = F.G * NWAVES;
    constexpr int I_IN = 32 * (NINP / 64), I_OUT = 32 * 32, I_UP = 32 * (NUP / 64), I_DOWN = (DFF / 64) * 32, I_C1 = 4 * 32 * 2, I_LAYER = I_IN + I_OUT + I_UP + I_DOWN + I_C1;
    (void)gw; (void)NGW;
    constexpr int I_ALL = DEPTH * I_LAYER, CHUNK = 4, N_TICKETS = (I_ALL + CHUNK - 1) / CHUNK;
    WQ q; q.base = (unsigned*)(ld_ws() + WS_CTL + CTL_WQ_COPY); q.per_shard = (N_TICKETS + 7) / 8; q.shard = F.bx & 7; q.tried = 0;
    for (int tk = wq_next(q, lane_d), nx; tk >= 0; tk = nx) {
        nx = wq_next(q, lane_d);
        for (int it = tk * CHUNK; it < tk * CHUNK + CHUNK && it < I_ALL; ++it) {
            const int l = it / I_LAYER; int r = it % I_LAYER;
            if (r < I_IN) { p0_transpose_item<1>(ld_in(6) + (size_t)l * 2048 * DIN, 2048, DIN, NINP / 64, wl(l, W_IN), 0, scr, r, lane_d); continue; } r -= I_IN;
            if (r < I_OUT) { p0_transpose_item<0>(ld_in(14) + (size_t)l * 2048 * 2048, 2048, 2048, 32, wl(l, W_OUT), 0, scr, r, lane_d); continue; } r -= I_OUT;
            if (r < I_UP) { p0_transpose_item<2>(ld_in(15) + (size_t)l * 2048 * NUP, 2048, NUP, NUP / 64, wl(l, W_UP), 0, scr, r, lane_d); continue; } r -= I_UP;
            if (r < I_DOWN) { p0_transpose_item<0>(ld_in(18) + (size_t)l * DFF * 2048, DFF, 2048, 32, wl(l, W_DOWN), 0, scr, r, lane_d); continue; } r -= I_DOWN;
            { const int qq = r >> 6, kv = qq >> 1, half = qq & 1; r &= 63;
              const float* w1 = ld_in(10 + 2 * kv) + (size_t)l * 4096 * 128 + (size_t)half * 2048 * 128;
              p0_transpose_item<0>(w1, 2048, 128, 2, wl(l, W_C1) + (size_t)kv * 256 * 2048, half * 128, scr, r, lane_d); }
        }
    }
}

__device__ __forceinline__ void p_gate(Frame& F, int l) {
    PH_IDS();
    typedef short bf16x8_t __attribute__((ext_vector_type(8)));
    const int gw = F.vcu * NWAVES + wave, NGW = F.G * NWAVES, fr = lane & 15, fq = lane >> 4;
    const bf16* Wg = wl(l, W_IN) + (size_t)5632 * 2048 + (size_t)fr * 2048 + 32 * fq;
    const float* bfg = ld_in(7) + l * 8;
    for (int t = gw; t < MROWS / 16; t += NGW) {
        const int row = 16 * t + fr, b = row >> 11, tk = row & 2047;
        const bf16* Hp = WSP(bf16, WS_H) + (size_t)row * 2048 + 32 * fq;
        f32x4 acc0 = (f32x4){0.f, 0.f, 0.f, 0.f}, acc1 = acc0;
#pragma unroll 4
        for (int kk = 0; kk < 16; ++kk) {
            bf16x8_t hb[4], w0[4], w1[4];
#pragma unroll
            for (int q = 0; q < 4; ++q) { hb[q] = *(const bf16x8_t*)(Hp + kk * 128 + 8 * q); w0[q] = *(const bf16x8_t*)(Wg + kk * 128 + 8 * q); w1[q] = *(const bf16x8_t*)(Wg + (size_t)16 * 2048 + kk * 128 + 8 * q); }
#pragma unroll
            for (int q = 0; q < 4; ++q) {
                acc0 = __builtin_amdgcn_mfma_f32_16x16x32_bf16(w0[q], hb[q], acc0, 0, 0, 0);
                acc1 = __builtin_amdgcn_mfma_f32_16x16x32_bf16(w1[q], hb[q], acc1, 0, 0, 0); }
        }
        const float* sq = (const float*)(ld_ws() + WS_SSQ + (size_t)(2 * l) * SSQ_BYTES) + (size_t)row * 8;
        const f32x4 s0 = *(const f32x4*)sq, s1 = *(const f32x4*)(sq + 4);
        const float rstd = __builtin_amdgcn_rsqf((((s0[0] + s0[1]) + (s0[2] + s0[3])) + ((s1[0] + s1[1]) + (s1[2] + s1[3]))) * (1.0f / 2048.0f) + 1e-6f);
        const float* bp = (const float*)(ld_ws() + WS_BIAS) + ((size_t)l * 16 + b) * NINP + 5632 + 4 * fq;
        const f32x4 b0 = *(const f32x4*)bp, b1 = *(const f32x4*)(bp + 16);
        float* LOGF = WSP(float, WS_LOGF); float* G3 = WSP(float, WS_G3);
#pragma unroll
        for (int e = 0; e < 4; ++e) {
            { const int p = 4 * fq + e; const float v = acc0[e] * rstd + b0[e];
              if (p < 8) { const float x = v + bfg[p]; LOGF[(size_t)(b * 8 + p) * 2048 + tk] = fminf(x, 0.f) - __logf(1.0f + __expf(-fabsf(x))); }
              else { const int q = p - 8, h = q / 3, j = q - 3 * h; G3[(size_t)((b * 8 + h) * 3 + j) * 2048 + tk] = __builtin_amdgcn_rcpf(1.0f + __expf(-v)); } }
            { const int q = 16 + 4 * fq + e - 8, h = q / 3, j = q - 3 * h; const float v = acc1[e] * rstd + b1[e];
              G3[(size_t)((b * 8 + h) * 3 + j) * 2048 + tk] = __builtin_amdgcn_rcpf(1.0f + __expf(-v)); }
        }
    }
}
constexpr int BT_IN = NINP / 16, BT_UP = NUP / 16, BT_ALL = 2 * (BT_IN + BT_UP);
__device__ __forceinline__ void bias_task(int t, int lane) {
    typedef short bf16x8_t __attribute__((ext_vector_type(8)));
    const int fr = lane & 15, fq = lane >> 4;
    int l, r0; bool up;
    if (t < 2 * BT_IN) { up = false; l = t / BT_IN; r0 = (t % BT_IN) * 16; } else { up = true; l = (t - 2 * BT_IN) / BT_UP; r0 = ((t - 2 * BT_IN) % BT_UP) * 16; }
    const bf16* W = wl(l, up ? W_UP : W_IN) + (size_t)(r0 + fr) * 2048 + 8 * fq;
    const float* sh = WSP(float, WS_MOD) + ((size_t)l * 16 + fr) * 12288 + (up ? 3 : 0) * 2048 + 8 * fq;
    f32x4 acc = (f32x4){0.f, 0.f, 0.f, 0.f};
#pragma unroll 8
    for (int kt = 0; kt < 64; ++kt) {
        const bf16x8_t a = *(const bf16x8_t*)(W + kt * 32);
        const f32x4 s0 = *(const f32x4*)(sh + kt * 32), s1 = *(const f32x4*)(sh + kt * 32 + 4);
        v4u pb; pb.x = pk2(s0.x, s0.y); pb.y = pk2(s0.z, s0.w); pb.z = pk2(s1.x, s1.y); pb.w = pk2(s1.z, s1.w);
        acc = __builtin_amdgcn_mfma_f32_16x16x32_bf16(a, __builtin_bit_cast(bf16x8_t, pb), acc, 0, 0, 0);
    }
    float* out = (float*)(ld_ws() + WS_BIAS + (up ? BIAS_UP_OFF : 0)) + ((size_t)l * 16 + fr) * (up ? NUP : NINP) + r0 + 4 * fq;
    *(f32x4*)out = acc;
}
__device__ __forceinline__ void p_phase1(Frame& F, const float* x, const float* g, const float* mod_l, int sc_chunk, bf16* H, float* ssq) {
    PH_IDS();
    const int gw = F.vcu * NWAVES + wave, NGW = F.G * NWAVES;
    if (gw < BT_ALL) bias_task(gw, lane);
    const int nb_extra = BT_ALL > NGW ? BT_ALL - NGW : 0;
    if (NGW < BT_ALL - nb_extra) return;
    WQ q; q.base = (unsigned*)(ld_ws() + WS_CTL + CTL_WQ_NORM); q.per_shard = (nb_extra + MROWS / 4 + 7) / 8; q.shard = F.bx & 7; q.tried = 0;
    for (int tk = wq_next(q, lane), nx; tk >= 0; tk = nx) {
        nx = wq_next(q, lane);
        if (tk < nb_extra) { bias_task(NGW + tk, lane); continue; }
        const int m0 = 4 * (tk - nb_extra); if (m0 >= MROWS) continue;
        const int b = m0 >> 11;
        f32x4 v[4][8];
#pragma unroll
        for (int r = 0; r < 4; ++r) { const f32x4* xr = (const f32x4*)(x + (size_t)(m0 + r) * DM) + lane;
#pragma unroll
            for (int j = 0; j < 8; ++j) v[r][j] = __builtin_nontemporal_load(&xr[64 * j]); }
        const f32x4* gp = (const f32x4*)g + lane; const f32x4* scp = (const f32x4*)(mod_l + (size_t)b * 12288 + sc_chunk * 2048) + lane;
        f32x4 gs[8];
#pragma unroll
        for (int j = 0; j < 8; ++j) gs[j] = gp[64 * j] * (scp[64 * j] + 1.0f);
        float tot[4];
#pragma unroll
        for (int r = 0; r < 4; ++r) { float sacc = 0.f;
#pragma unroll
            for (int j = 0; j < 8; ++j) sacc += (v[r][j].x * v[r][j].x + v[r][j].y * v[r][j].y) + (v[r][j].z * v[r][j].z + v[r][j].w * v[r][j].w);
            tot[r] = sacc; }
#pragma unroll
        for (int o = 1; o < 64; o <<= 1) {
#pragma unroll
            for (int r = 0; r < 4; ++r) tot[r] += bperm(tot[r], lane ^ o); }
#pragma unroll
        for (int r = 0; r < 4; ++r) { v2u* o8 = (v2u*)(H + (size_t)(m0 + r) * DM) + lane;
#pragma unroll
            for (int j = 0; j < 8; ++j) { const f32x4 y = v[r][j] * gs[j]; v2u w; w.x = pk2(y.x, y.y); w.y = pk2(y.z, y.w); o8[64 * j] = w; }
            if (lane < 8) ssq[(size_t)(m0 + r) * 8 + lane] = lane == 0 ? tot[r] : 0.f; }
    }
}
__device__ __forceinline__ void p_final_norm(Frame& F, const float* g, const bf16* xb, float* out) {
    PH_IDS();
    const int gw = F.vcu * NWAVES + wave, NGW = F.G * NWAVES;
    v2u v[8], vn[8]; f32x4 gg[8];
#pragma unroll
    for (int j = 0; j < 8; ++j) gg[j] = *(const f32x4*)(g + 256 * j + 4 * lane);
    if (gw < MROWS) { const bf16* xr = xb + (size_t)gw * DM + 4 * lane;
#pragma unroll
        for (int j = 0; j < 8; ++j) v[j] = *(const v2u*)(xr + 256 * j); }
    for (int m = gw; m < MROWS; m += NGW) {
        if (m + NGW < MROWS) { const bf16* xr = xb + (size_t)(m + NGW) * DM + 4 * lane;
#pragma unroll
            for (int j = 0; j < 8; ++j) vn[j] = *(const v2u*)(xr + 256 * j); }
        f32x4 x[8]; float s = 0.f;
#pragma unroll
        for (int j = 0; j < 8; ++j) { const v2u w = v[j];
            x[j] = (f32x4){__builtin_bit_cast(float, w.x << 16), __builtin_bit_cast(float, w.x & 0xffff0000u), __builtin_bit_cast(float, w.y << 16), __builtin_bit_cast(float, w.y & 0xffff0000u)};
            s += (x[j].x * x[j].x + x[j].y * x[j].y) + (x[j].z * x[j].z + x[j].w * x[j].w); }
        const float rstd = 1.0f / sqrtf(wave_sum(s, lane) * (1.0f / DM) + RMS_EPS);
        float* xw = out + (size_t)m * DM + 4 * lane;
#pragma unroll
        for (int j = 0; j < 8; ++j) *(f32x4*)(xw + 256 * j) = (x[j] * rstd) * gg[j];
#pragma unroll
        for (int j = 0; j < 8; ++j) v[j] = vn[j];
    }
}

__device__ __forceinline__ void p_cumsum(Frame& F, const float* LOGF, float* KBIAS) {
    PH_IDS();
    const int gw = F.vcu * NWAVES + wave, NGW = F.G * NWAVES;
    for (int u = gw; u < 128; u += NGW) {
        const float* lf = LOGF + (size_t)u * 2048 + 32 * lane; float* kb = KBIAS + (size_t)u * 2048 + 32 * lane;
        float v[32];
#pragma unroll
        for (int j = 0; j < 8; ++j) { const f32x4 x = *(const f32x4*)(lf + 4 * j); v[4 * j] = x.x; v[4 * j + 1] = x.y; v[4 * j + 2] = x.z; v[4 * j + 3] = x.w; }
#pragma unroll
        for (int j = 1; j < 32; ++j) v[j] += v[j - 1];
        float tot = v[31], inc = tot;
#pragma unroll
        for (int o = 1; o < 64; o <<= 1) { const float t = bperm(inc, lane >= o ? lane - o : lane); if (lane >= o) inc += t; }
        const float base = inc - tot;
#pragma unroll
        for (int j = 0; j < 8; ++j) { f32x4 y; y.x = -(v[4 * j] + base) * 11.313708498984761f; y.y = -(v[4 * j + 1] + base) * 11.313708498984761f; y.z = -(v[4 * j + 2] + base) * 11.313708498984761f; y.w = -(v[4 * j + 3] + base) * 11.313708498984761f;
            *(f32x4*)(kb + 4 * j) = y; }
    }
}

__device__ __forceinline__ void p_compress2_unit(Frame& F, int l, int unit) {
    PH_IDS();
    const int kv = unit >> 7, bk = (unit >> 2) & 31, qt = unit & 3, b = bk >> 1, hkv = bk & 1, n0 = 32 * qt;
    LAS float* hid = (LAS float*)LDSL;
    LAS float* w2s = (LAS float*)(LDSL + 32 * 129 * 4 + 16);
    const float* T1 = WSP(float, WS_T1) + (size_t)kv * 4096 * 256 + (size_t)((hkv * 16 + b) * 128) * 256;
    const float* pp = WSP(float, WS_POSB) + (l * 2 + kv) * 128;
    const float* w2 = ld_in(11 + 2 * kv) + (size_t)l * 128 * 128;
    LAS float* posb = w2s;
    f32x4 wreg[8];
#pragma unroll
    for (int q = 0; q < 8; ++q) wreg[q] = *(const f32x4*)(w2 + 4 * (tid + NTHREADS * q));
    float t1a[8], t1b[8];
#pragma unroll
    for (int it = 0; it < 8; ++it) { const int i = tid + NTHREADS * it, nl = i >> 7, j = i & 127, n = n0 + nl; t1a[it] = 0.f; t1b[it] = 0.f;
        if (n < 127) { t1a[it] = T1[(size_t)n * 256 + j]; t1b[it] = T1[(size_t)(n + 1) * 256 + 128 + j]; } }
    { const int j = tid & 127, part = tid >> 7; float sp0 = 0.f, sp1 = 0.f, sp2 = 0.f, sp3 = 0.f;
#pragma unroll
      for (int q = 0; q < 64; q += 4) { const float* pq = pp + (size_t)(part * 64 + q) * 512 + j; sp0 += pq[0]; sp1 += pq[512]; sp2 += pq[1024]; sp3 += pq[1536]; }
      posb[part * 128 + j] = (sp0 + sp1) + (sp2 + sp3); }
    __syncthreads();
#pragma unroll
    for (int it = 0; it < 8; ++it) { const int i = tid + NTHREADS * it, nl = i >> 7, j = i & 127, n = n0 + nl;
        float hv = 0.f;
        if (n < 127) { const float x = t1a[it] + t1b[it] + ((posb[j] + posb[128 + j]) + (posb[256 + j] + posb[384 + j]));
            const float u = 0.7978845608028654f * (x + 0.044715f * x * x * x); hv = 0.5f * x * (1.0f + tanhf(u)); }
        hid[nl * 129 + j] = hv; }
    __syncthreads();
#pragma unroll
    for (int q = 0; q < 8; ++q) *(LAS f32x4*)(w2s + 4 * (tid + NTHREADS * q)) = wreg[q];
    __syncthreads();
    const int nl = tid >> 4, eg = tid & 15, n = n0 + nl;
    float acc[8];
#pragma unroll
    for (int e = 0; e < 8; ++e) acc[e] = 0.f;
#pragma unroll 4
    for (int j = 0; j < 128; ++j) { const float h = hid[nl * 129 + j]; const LAS f32x4* wp = (const LAS f32x4*)(w2s + j * 128 + eg * 8);
        const f32x4 wa = wp[0], wb = wp[1];
        acc[0] += h * wa.x; acc[1] += h * wa.y; acc[2] += h * wa.z; acc[3] += h * wa.w; acc[4] += h * wb.x; acc[5] += h * wb.y; acc[6] += h * wb.z; acc[7] += h * wb.w; }
    if (kv == 0) { v4u w; w.x = pk2(acc[0], acc[1]); w.y = pk2(acc[2], acc[3]); w.z = pk2(acc[4], acc[5]); w.w = pk2(acc[6], acc[7]);
        *(v4u*)(WSP(bf16, WS_KCMP) + ((size_t)bk * 128 + n) * 128 + eg * 8) = w; }
    else { bf16* o = WSP(bf16, WS_VCMPT) + (size_t)bk * 128 * 128 + n;
#pragma unroll
        for (int e = 0; e < 8; ++e) o[(size_t)(eg * 8 + e) * 128] = (bf16)f2bf(acc[e]); }
    __syncthreads();
}

constexpr int CMP_TILE = 16384;
__device__ __forceinline__ void p_cmp_super(Frame& F, int su, const float gscale  ) {
    PH_IDS();
    const int bk = su >> 3, b = bk >> 1, hkv = bk & 1;
    const int wid = wave, r32 = lane & 31, hi = lane >> 5;
    char* ldsb = (char*)g_lds;
    { const int sr = tid >> 4, sc = (tid & 15) * 8, kws = KSWZ(sr, sc * 2);
      const bf16* Kc = WSP(bf16, WS_KCMP) + (size_t)bk * 128 * 128; const bf16* Vt = WSP(bf16, WS_VCMPT) + (size_t)bk * 128 * 128;
      bf16x8 t[8];
#pragma unroll
      for (int q = 0; q < 4; ++q) { const bf16* src = (q < 2 ? Kc : Vt) + (size_t)(64 * (q & 1)) * 128; t[2 * q] = *(const bf16x8*)(src + (size_t)sr * 128 + sc); t[2 * q + 1] = *(const bf16x8*)(src + (size_t)(32 + sr) * 128 + sc); }
#pragma unroll
      for (int q = 0; q < 4; ++q) { *(bf16x8*)(ldsb + q * CMP_TILE + kws) = t[2 * q]; *(bf16x8*)(ldsb + q * CMP_TILE + kws + 32 * 256) = t[2 * q + 1]; } }
    __syncthreads();
    constexpr float C2 = 1.4426950408889634f * att::SCALE; const float NEG = -__builtin_inff();
    const int tq = (su & 7) * 256 + wid * 32 + r32;
    int nvalid = 0; if (tq >= 31) { nvalid = (tq - 31) / 16 + 1; if (nvalid > 127) nvalid = 127; }
    float imp[16];
#pragma unroll
    for (int q = 0; q < 16; ++q) imp[q] = 0.f;
#pragma unroll 1
    for (int g = 0; g < 4; ++g) {
        const int h = 4 * hkv + g;
        const bf16* Qp = WSP(bf16, WS_Z) + zoff(24 + h, b) + (size_t)tq * 128;
        bf16x8 qr[8];
#pragma unroll
        for (int d0 = 0; d0 < 8; ++d0) qr[d0] = *(const bf16x8*)(Qp + d0 * 16 + hi * 8);
        const float g0 = WSP(float, WS_G3)[(size_t)((b * 8 + h) * 3 + 0) * 2048 + tq] * gscale;
        att::f32x16 p[4];
        att::qkt<0, false>(p[0], p[1], ldsb, r32, hi, qr, true);
        att::qkt<1, false>(p[2], p[3], ldsb, r32, hi, qr, true);
        float mx = NEG; int nv = nvalid; asm volatile("" : "+v"(nv));
#pragma unroll
        for (int kg = 0; kg < 4; ++kg)
#pragma unroll
            for (int r = 0; r < 16; ++r) { const int key = 32 * kg + crow(r, hi); const float sv = key < nv ? p[kg][r] * C2 : NEG; p[kg][r] = sv; mx = fmaxf(mx, sv); }
        { auto rr = __builtin_amdgcn_permlane32_swap(__float_as_uint(mx), __float_as_uint(mx), false, false); mx = fmaxf(__uint_as_float(rr[0]), __uint_as_float(rr[1])); }
        const float ms = nvalid > 0 ? mx : 0.f;
        float sum = 0.f;
#pragma unroll
        for (int kg = 0; kg < 4; ++kg)
#pragma unroll
            for (int r = 0; r < 16; ++r) { const float e = __builtin_amdgcn_exp2f(p[kg][r] - ms); p[kg][r] = e; sum += e; }
        { auto rr = __builtin_amdgcn_permlane32_swap(__float_as_uint(sum), __float_as_uint(sum), false, false); sum = __uint_as_float(rr[0]) + __uint_as_float(rr[1]); }
        const float inv = nvalid > 0 ? 1.0f / sum : 0.f;
#pragma unroll
        for (int kg = 0; kg < 4; ++kg)
#pragma unroll
            for (int a = 0; a < 4; ++a) imp[4 * kg + a] += ((p[kg][4 * a] + p[kg][4 * a + 1]) + (p[kg][4 * a + 2] + p[kg][4 * a + 3])) * inv;
        const float scl = inv * g0;
#pragma unroll
        for (int kg = 0; kg < 4; ++kg)
#pragma unroll
            for (int r = 0; r < 16; ++r) p[kg][r] *= scl;
        bf16x8 pa[8];
#pragma unroll
        for (int kg = 0; kg < 4; ++kg) { ATT_PK4(p[kg], 0, pa[2 * kg]); ATT_PK4(p[kg], 8, pa[2 * kg + 1]); }
        int hi_e = hi, r32_e = r32; asm volatile("" : "+v"(hi_e), "+v"(r32_e));
        const int le = hi_e * 32 + r32_e, rrow = le >> 4, cb = (le & 15) * 16;
        bf16* Og = WSP(bf16, WS_O) + ((size_t)(b * 2048 + (su & 7) * 256 + wid * 32 + rrow)) * 2048 + 1024 + h * 128 + (cb >> 1);
        att::u32x4 sv[8], old[8];
#pragma unroll
        for (int j = 0; j < 8; ++j) old[j] = *(const att::u32x4*)(Og + (size_t)(4 * j) * 2048);
        att::f32x16 o[4];
#pragma unroll
        for (int d0 = 0; d0 < 4; ++d0) { o[d0] = att::f32x16{};
            const char* vbase = ldsb + (2 + (d0 >> 1)) * CMP_TILE;
#pragma unroll
            for (int ks = 0; ks < 8; ++ks) { const bf16x8 vb = *(const bf16x8*)(vbase + KSWZ(32 * (d0 & 1) + r32, 32 * ks + 16 * hi)); o[d0] = __builtin_amdgcn_mfma_f32_32x32x16_bf16(pa[ks], vb, o[d0], 0, 0, 0); } }
        {
            char* stg = ldsb + 73728 + wid * 8704; char* wp = stg + (4 * hi_e) * 272 + r32_e * 2;
#pragma unroll
            for (int d0 = 0; d0 < 4; ++d0) {
                float n16[16];
#pragma unroll
                for (int r = 0; r < 16; ++r) n16[r] = dpp_xor1(o[d0][r]);
                if ((r32 & 1) == 0) {
#pragma unroll
                    for (int r = 0; r < 16; ++r) *(unsigned*)(wp + crow(r, 0) * 272 + d0 * 64) = cvtpk(o[d0][r], n16[r]);
                }
            }
            asm volatile("s_waitcnt lgkmcnt(0)" ::: "memory");
            const char* rp = stg + rrow * 272 + cb;
#pragma unroll
            for (int j = 0; j < 8; ++j) sv[j] = *(const att::u32x4*)(rp + (4 * j) * 272);
#pragma unroll
            for (int j = 0; j < 8; ++j) { att::u32x4 w;
#pragma unroll
                for (int e = 0; e < 4; ++e) w[e] = cvtpk(__uint_as_float(sv[j][e] << 16) + __uint_as_float(old[j][e] << 16), __uint_as_float(sv[j][e] & 0xffff0000u) + __uint_as_float(old[j][e] & 0xffff0000u));
                *(att::u32x4*)(Og + (size_t)(4 * j) * 2048) = w; }
        }
    }
    { const int cur = tq >> 6;
      float own[16], oth[16];
#pragma unroll
      for (int q = 0; q < 16; ++q) { auto rr = __builtin_amdgcn_permlane32_swap(__float_as_uint(imp[q]), __float_as_uint(imp[q]), false, false);
          const float lo_v = __uint_as_float(rr[0]), hi_v = __uint_as_float(rr[1]);
          const float ot = hi ? lo_v : hi_v;
          const int jv = 2 * q + hi, jo = 2 * q + 1 - hi;
          own[q] = (jv <= cur) ? imp[q] + (((jv == 0) || (jv == cur) || (jv == cur - 1)) ? 1000.0f : 0.0f) : -1e30f;
          oth[q] = (jo <= cur) ? ot + (((jo == 0) || (jo == cur) || (jo == cur - 1)) ? 1000.0f : 0.0f) : -1e30f; }
      unsigned bits = 0u;
#define CNT_GT(x) asm("v_cmp_gt_f32 vcc, %1, %2\n\tv_addc_co_u32 %0, vcc, 0, %0, vcc" : "+v"(cnt) : "v"(x), "v"(sj) : "vcc")
#define CNT_EQ(x) asm("v_cmp_eq_f32 vcc, %1, %2\n\tv_addc_co_u32 %0, vcc, 0, %0, vcc" : "+v"(cnt) : "v"(x), "v"(sj) : "vcc")
#pragma unroll
      for (int q = 0; q < 16; ++q) { const float sj = own[q]; int cnt = 0;
#pragma unroll
          for (int i = 0; i < 16; ++i) { CNT_GT(own[i]); CNT_GT(oth[i]); if (i < q) { CNT_EQ(own[i]); CNT_EQ(oth[i]); } }
          cnt += (oth[q] == sj && hi != 0) ? 1 : 0;
          bits |= (cnt < 16 ? 1u : 0u) << (2 * q); }
#undef CNT_GT
#undef CNT_EQ
      const unsigned half = bits << hi;
      auto rr = __builtin_amdgcn_permlane32_swap(half, half, false, false);
      if (hi == 0) WSP(unsigned, WS_SELM)[(size_t)bk * 2048 + tq] = rr[0] | rr[1]; }
    __syncthreads();
}

template <int MODE>
__device__ __forceinline__ att::BlockRef att_ref(int idx) {
    const int qb = 7 - (idx >> 7), j = idx & 127;
    const int b = (MODE == 0) ? (j >> 3) : ((j & 31) >> 1), h = (MODE == 0) ? (j & 7) : (4 * (j & 1) + (j >> 5)), bh = b * 8 + h;
    att::BlockRef r; r.P0 = qb * 256; r.x = 0; r.s = 0;
    const unsigned qoff = (unsigned)qb * 256u * 128u;
    if (MODE == 0) { r.q = zoff(h, b) + qoff; r.k = zoff(8 + h, b); r.v = zoff(16 + h, b); r.o = (unsigned)(b * 2048 + qb * 256) * 2048u + h * 128; r.x = (unsigned)bh * 2048u; }
    else { const int hk = h >> 2;
        r.q = zoff(24 + h, b) + qoff; r.k = zoff((MODE == 1 ? 40 : 36) + hk, b); r.v = zoff((MODE == 1 ? 42 : 38) + hk, b);
        r.o = (unsigned)(b * 2048 + qb * 256) * 2048u + 1024 + h * 128;
        r.x = (unsigned)(bh * 3 + (MODE == 1 ? 2 : 1)) * 2048u; r.s = (unsigned)(b * 2 + hk) * 2048u; }
    return r;
}
__device__ __forceinline__ int att_item(int c, int G, int r) { return r * G + ((r & 1) ? G - 1 - c : c); }
__device__ __forceinline__ int fox_item(int c, int G, int r) {
    if (G != 256) return r * G + ((r & 1) ? G - 1 - c : c);
    if (r > 3) return 1024;
    const int x = c & 7, w = c >> 3, j = 16 * x + 8 * (r >> 1) + (w >> 2), qb = (r & 1) ? (w & 3) : 7 - (w & 3);
    return (7 - qb) * 128 + j;
}
__device__ __forceinline__ int win_item(int c, int G, int r) {
    if (G != 256) return att_item(c, G, r);
    const int cq = (c & 31) + 32 * (c >> 7), g = (c >> 5) & 3;
    int qb, bk;
    if (cq < 8) { if (r == 0) { qb = 7; bk = cq; } else if (r == 1) { qb = 1; bk = cq; } else return 1024; }
    else { const int k = cq - 8;
        if (r < 3) { const int t = 8 + 3 * k + r; qb = 7 - (t >> 5); bk = t & 31; }
        else if (k < 16) { if (r != 3) return 1024; const int t = 176 + k; qb = 7 - (t >> 5); bk = t & 31; }
        else if (k < 40) { if (r != 3) return 1024; qb = 1; bk = 8 + (k - 16); }
        else { if (r > 4) return 1024; qb = 0; bk = 2 * (k - 40) + (r - 3); } }
    return (7 - qb) * 128 + g * 32 + bk;
}
__device__ __forceinline__ int cmp1_slot(int c, int G) { if (G != 256) return c < 32 ? c : -1; return (c < 128 && (c & 31) < 8) ? (c & 31) + 8 * (c >> 5) : -1; }
template <int MODE, int VAR = 0>
__device__ __forceinline__ void p_attention(Frame& F, const bool st = true) {
    const int c = F.bx, G = F.G; const int tid = otid(F.wave_id);
    int r = 0; int idx = (MODE == 1) ? win_item(c, G, 0) : (MODE == 0 ? fox_item(c, G, 0) : att_item(c, G, 0)); if (idx >= 1024) return;
    att::Bases BS; BS.Zb = (const att::bf16*)WSP(bf16, WS_Z); BS.Ob = (att::bf16*)WSP(bf16, WS_O); BS.Xf = (MODE == 0) ? WSP(float, WS_KBIAS) : WSP(float, WS_G3); BS.Sel = WSP(unsigned, WS_SELM); BS.st = st;
    att::BlockRef cur = att_ref<MODE>(idx);
    att::Seam S;
    att::att_prime<MODE, VAR>(BS, cur, (char*)g_lds, S, tid);
    for (;;) {
        const int nidx = (MODE == 1) ? win_item(c, G, r + 1) : (MODE == 0 ? fox_item(c, G, r + 1) : att_item(c, G, r + 1)); const bool last = nidx >= 1024;
        const att::BlockRef nxt = last ? cur : att_ref<MODE>(nidx);
        att::att_block<MODE, VAR>(BS, cur, nxt, SEQ, (char*)g_lds, S, tid);
        if (last) break;
        cur = nxt; ++r;
    }
}

__device__ __forceinline__ f32x4 ld_bf4(const bf16* p) { const v2u w = *(const v2u*)p; f32x4 r; r.x = __builtin_bit_cast(float, w.x << 16); r.y = __builtin_bit_cast(float, w.x & 0xffff0000u); r.z = __builtin_bit_cast(float, w.y << 16); r.w = __builtin_bit_cast(float, w.y & 0xffff0000u); return r; }
__device__ __forceinline__ void p_fixup(Frame& F, int l) {
    PH_IDS();
    const float* cw = ld_in(16) + (size_t)l * 3 * NUP; const float* cb = ld_in(17) + (size_t)l * NUP; const bf16* SIDE = WSP(bf16, WS_SIDE); bf16* ACT = WSP(bf16, WS_ACT);
    const int NC = DFF / 4, NT_ = F.G * NTHREADS, NS = NT_ / NC;
    const int gt = F.vcu * NTHREADS + tid; const int jc = gt % NC, gslot = gt / NC;
    if (gslot >= NS) return;
    const int j = 4 * jc;
    f32x4 w0[2], w1[2], w2[2], bb[2];
#pragma unroll
    for (int q = 0; q < 2; ++q) { const int col = q * DFF + j; w0[q] = *(const f32x4*)(cw + col); w1[q] = *(const f32x4*)(cw + NUP + col); w2[q] = *(const f32x4*)(cw + 2 * NUP + col); bb[q] = *(const f32x4*)(cb + col); }
#pragma unroll 2
    for (int grp = gslot; grp < 512; grp += NS) {
        if ((grp & 31) == 0) continue;
        const bf16* sp = SIDE + (size_t)(grp - 1) * 4 * NUP; const bf16* sc = SIDE + (size_t)grp * 4 * NUP;
        f32x4 y0[2], y1[2];
#pragma unroll
        for (int q = 0; q < 2; ++q) { const int col = q * DFF + j;
            const f32x4 um2 = ld_bf4(sp + 2 * NUP + col), um1 = ld_bf4(sp + 3 * NUP + col), u0 = ld_bf4(sc + col), u1 = ld_bf4(sc + NUP + col);
            y0[q] = bb[q] + w0[q] * um2 + w1[q] * um1 + w2[q] * u0; y1[q] = bb[q] + w0[q] * um1 + w1[q] * u0 + w2[q] * u1; }
        f32x4 a0, a1;
#pragma unroll
        for (int e = 0; e < 4; ++e) { a0[e] = y0[0][e] * pg8::fast_sigmoid(y0[0][e]) * y0[1][e]; a1[e] = y1[0][e] * pg8::fast_sigmoid(y1[0][e]) * y1[1][e]; }
        v2u o0, o1; o0.x = pg8::cvt_pk_bf16(a0[0], a0[1]); o0.y = pg8::cvt_pk_bf16(a0[2], a0[3]); o1.x = pg8::cvt_pk_bf16(a1[0], a1[1]); o1.y = pg8::cvt_pk_bf16(a1[2], a1[3]);
        *(v2u*)(ACT + (size_t)(grp * 64) * DFF + j) = o0; *(v2u*)(ACT + (size_t)(grp * 64 + 1) * DFF + j) = o1;
    }
}

constexpr int NPH_LAYER = 11, NPH = 1 + DEPTH * NPH_LAYER + 1;
#ifndef MK_PHASE_MASK
#define MK_PHASE_MASK 0xffffffffu
#endif
#ifndef MK_SUB
#define MK_SUB 7
#endif
#define ON(j) ((MK_PHASE_MASK >> (j)) & 1u)
#ifndef MK_REP_MASK
#define MK_REP_MASK 0u
#endif
#define NREP(j) (((MK_REP_MASK >> (j)) & 1u) ? 2 : 1)
__global__ void __launch_bounds__(NTHREADS, 2) mk_fwd(Args args) {
    const int wave_id = __builtin_amdgcn_readfirstlane((int)threadIdx.x >> 6);
    volatile LAS unsigned* MISC = (volatile LAS unsigned*)(LDSL + MISC_OFF);
    for (int u = threadIdx.x; u < (LDS_BYTES - MISC_OFF) / 4; u += NTHREADS) MISC[u] = 0u;
    __syncthreads();
    const int lo = args.ph_lo, hi = args.ph_hi;
    const bool multi = (hi - lo) > 1;
    if (multi) (void)xcd_barrier_post((unsigned*)(ld_ws() + WS_CTL) + CW_BAR, MISC + 8);
#define IN(k) (lo <= (k) && (k) < hi)
#define FBAR() do { XcdBarrier b_; b_.bar = (unsigned*)(ld_ws() + WS_CTL) + CW_BAR; b_.x = xb_xcc_id(); b_.st = MISC + 8; xcd_barrier(b_, otid(wave_id) == 0); } while (0)
#define REP_BEGIN(j) for (int rep_ = 0; rep_ < NREP(j); ++rep_) { if (rep_) FBAR();
#define REP_END }
#define SEAM(k) do { if (IN(k) && IN((k) + 1)) { XcdBarrier b_; b_.bar = (unsigned*)(ld_ws() + WS_CTL) + CW_BAR; b_.x = xb_xcc_id(); b_.st = MISC + 8; xcd_barrier(b_, otid(wave_id) == 0); } } while (0)

#ifdef MK_EXTRA_BARRIERS
    for (int eb_ = 0; eb_ < MK_EXTRA_BARRIERS; ++eb_) FBAR();
#endif
    REP_BEGIN(0) if (ON(0) && IN(0)) { Frame F = mkframe(wave_id); p0_prologue(F); } REP_END SEAM(0);
    for (int l = 0; l < DEPTH; ++l) {
        const int pb = 1 + l * NPH_LAYER;
        const size_t modl = WS_MOD + (size_t)l * 16 * 12288 * 4;
        if (l == 0) { REP_BEGIN(1) if (ON(1) && IN(pb + 0)) { Frame F = mkframe(wave_id); p_phase1(F, ld_in(0), ld_in(2), WSP(float, WS_MOD), 1, WSP(bf16, WS_H), WSP(float, WS_SSQ)); } REP_END SEAM(pb + 0); }
        REP_BEGIN(2) if (ON(2) && IN(pb + 1)) { Frame F = mkframe(wave_id);
            pg8::Gemm g{WSP(bf16, WS_H), wl(l, W_IN), MROWS, 5632, DM}; pg8::StaticOrder S; S.init(MROWS, 5632, F.G, F.bx);
            pg8::EpiInProj E{ld_ws(), (const float*)(ld_ws() + WS_SSQ + (size_t)(2 * l) * SSQ_BYTES), (const float*)(ld_ws() + WS_BIAS) + (size_t)l * 16 * NINP};
            pg8::gemm_phase<pg8::EpiInProj, pg8::StaticOrder, true, true>(LDSL, g, S, E, otid(wave_id));
            p_gate(F, l);
        } REP_END SEAM(pb + 1);
        REP_BEGIN(3) if (ON(3) && IN(pb + 2)) { Frame F = mkframe(wave_id);
            if (MK_SUB & 1) {
            { pg8::Gemm g{WSP(bf16, WS_Z) + zoff(32, 0), wl(l, W_C1), 4096, 256, DM}; const int slot = cmp1_slot(F.bx, F.G); pg8::StaticOrder S; S.init(4096, 256, F.G, F.G != 256 ? F.bx : ((slot >= 0 && slot < 16) ? slot : 16));
              pg8::EpiF32 E{WSP(float, WS_T1), 256}; pg8::gemm_phase<pg8::EpiF32, pg8::StaticOrder, true, true>(LDSL, g, S, E, otid(wave_id)); }
            { pg8::Gemm g{WSP(bf16, WS_Z) + zoff(34, 0), wl(l, W_C1) + (size_t)256 * 2048, 4096, 256, DM}; const int slot = cmp1_slot(F.bx, F.G); pg8::StaticOrder S; S.init(4096, 256, F.G, F.G != 256 ? F.bx : (slot >= 16 ? slot - 16 : 16));
              pg8::EpiF32 E{WSP(float, WS_T1) + (size_t)4096 * 256, 256}; pg8::gemm_phase<pg8::EpiF32, pg8::StaticOrder, true, true>(LDSL, g, S, E, otid(wave_id)); }
            }
            if (MK_SUB & 2) p_cumsum(F, WSP(float, WS_LOGF), WSP(float, WS_KBIAS));
            __syncthreads();
            if (MK_SUB & 4) p_attention<1>(F);
        } REP_END SEAM(pb + 2);
        REP_BEGIN(4) if (ON(4) && IN(pb + 3)) { Frame F = mkframe(wave_id);
            if (MK_SUB & 1) for (int u = F.vcu; u < 256; u += F.G) p_compress2_unit(F, l, u);
#ifdef MK_FOX_VAR
            if (rep_ + 1 < NREP(4)) { p_attention<0, MK_FOX_VAR>(F, false); } else
#endif
            if (MK_SUB & 4) p_attention<0>(F);
        } REP_END SEAM(pb + 3);
        REP_BEGIN(5) if (ON(5) && IN(pb + 4)) { Frame F = mkframe(wave_id); for (int u = F.bx; u < 256; u += F.G) p_cmp_super(F, u, rep_ == NREP(5) - 1 ? 1.0f : 0.0f); } REP_END SEAM(pb + 4);
        REP_BEGIN(6) if (ON(6) && IN(pb + 5)) { Frame F = mkframe(wave_id); p_attention<2>(F, rep_ == NREP(6) - 1); } REP_END SEAM(pb + 5);
        REP_BEGIN(7) if (ON(7) && IN(pb + 6)) { Frame F = mkframe(wave_id);
            pg8::Gemm g{WSP(bf16, WS_O), wl(l, W_OUT), MROWS, DM, DM}; pg8::StaticOrder S; S.init(MROWS, DM, F.G, F.bx);
            if (l == 0) {
                pg8::EpiRes<true, false> E{ld_in(0), WSP(bf16, WS_XB), (const float*)(ld_ws() + modl) + 2 * 2048, rep_ == NREP(7) - 1,
                                    WSP(bf16, WS_H), ld_in(3) + (size_t)l * DM, (const float*)(ld_ws() + modl) + 4 * 2048, (float*)(ld_ws() + WS_SSQ + (size_t)(2 * l + 1) * SSQ_BYTES), (LAS float*)(LDSL + 131072)};
                pg8::gemm_phase<pg8::EpiRes<true, false>, pg8::StaticOrder, true, true>(LDSL, g, S, E, otid(wave_id));
            } else {
                pg8::EpiRes<true, true> E{WSP(bf16, WS_XB), WSP(bf16, WS_XB), (const float*)(ld_ws() + modl) + 2 * 2048, rep_ == NREP(7) - 1,
                                    WSP(bf16, WS_H), ld_in(3) + (size_t)l * DM, (const float*)(ld_ws() + modl) + 4 * 2048, (float*)(ld_ws() + WS_SSQ + (size_t)(2 * l + 1) * SSQ_BYTES), (LAS float*)(LDSL + 131072)};
                pg8::gemm_phase<pg8::EpiRes<true, true>, pg8::StaticOrder, true, true>(LDSL, g, S, E, otid(wave_id));
            }
        } REP_END SEAM(pb + 6);
        REP_BEGIN(9) if (ON(9) && IN(pb + 8)) { Frame F = mkframe(wave_id);
            pg8::Gemm g{WSP(bf16, WS_H), wl(l, W_UP), MROWS, NUP, DM}; pg8::StaticOrder S; S.init(MROWS, NUP, F.G, F.bx);
            pg8::EpiConvGate E{WSP(bf16, WS_ACT), WSP(bf16, WS_SIDE), ld_in(16) + (size_t)l * 3 * NUP, ld_in(17) + (size_t)l * NUP,
                               (const float*)(ld_ws() + WS_SSQ + (size_t)(2 * l + 1) * SSQ_BYTES), (const float*)(ld_ws() + WS_BIAS + BIAS_UP_OFF) + (size_t)l * 16 * NUP, LDSL + 131072};
            pg8::gemm_phase<pg8::EpiConvGate, pg8::StaticOrder, true, true>(LDSL, g, S, E, otid(wave_id));
        } REP_END SEAM(pb + 8);
        REP_BEGIN(10) if (ON(10) && IN(pb + 9)) { Frame F = mkframe(wave_id); p_fixup(F, l); } REP_END SEAM(pb + 9);
        REP_BEGIN(11) if (ON(11) && IN(pb + 10)) { Frame F = mkframe(wave_id);
            pg8::Gemm g{WSP(bf16, WS_ACT), wl(l, W_DOWN), MROWS, DM, DFF}; pg8::StaticOrder S; S.init(MROWS, DM, F.G, F.bx);
            if (l + 1 < DEPTH) {
                pg8::EpiRes<true, true> E{WSP(bf16, WS_XB), WSP(bf16, WS_XB), (const float*)(ld_ws() + modl) + 5 * 2048, rep_ == NREP(11) - 1,
                                    WSP(bf16, WS_H), ld_in(2) + (size_t)(l + 1) * DM, (const float*)(ld_ws() + modl) + 16 * 12288 + 1 * 2048, (float*)(ld_ws() + WS_SSQ + (size_t)(2 * l + 2) * SSQ_BYTES), (LAS float*)(LDSL + 131072)};
                pg8::gemm_phase<pg8::EpiRes<true, true>, pg8::StaticOrder, true, true>(LDSL, g, S, E, otid(wave_id));
            } else {
                pg8::EpiRes<false, true> E{WSP(bf16, WS_XB), WSP(bf16, WS_XB), (const float*)(ld_ws() + modl) + 5 * 2048, rep_ == NREP(11) - 1, nullptr, nullptr, nullptr, nullptr, nullptr};
                pg8::gemm_phase<pg8::EpiRes<false, true>, pg8::StaticOrder, true, true>(LDSL, g, S, E, otid(wave_id));
            }
        } REP_END SEAM(pb + 10);
    }
    REP_BEGIN(12) if (ON(12) && IN(NPH - 1)) { Frame F = mkframe(wave_id); p_final_norm(F, ld_in(19), WSP(bf16, WS_XB), ld_out()); } REP_END
#undef IN
#undef SEAM
}

extern "C" void kernel_launch(void* const* d_in, const int* in_sizes, int n_in, void* d_out, int out_size, void* d_ws, size_t ws_size, hipStream_t stream) {
    static int grid = 0;
    if (grid == 0) {
        if (n_in != 20 || out_size != MROWS * DM || ws_size < WS_END) { fprintf(stderr, "kernel_launch: unexpected shapes (n_in %d, out %d, ws %zu)\n", n_in, out_size, ws_size); grid = -1; return; }
        int dev = 0, cus = 0, per_cu = 0;
        if (hipGetDevice(&dev) != hipSuccess || hipDeviceGetAttribute(&cus, hipDeviceAttributeMultiprocessorCount, dev) != hipSuccess) { grid = -1; return; }
        if (hipFuncSetAttribute((const void*)mk_fwd, hipFuncAttributeMaxDynamicSharedMemorySize, LDS_BYTES) != hipSuccess) { fprintf(stderr, "kernel_launch: hipFuncSetAttribute failed\n"); grid = -1; return; }
        if (hipOccupancyMaxActiveBlocksPerMultiprocessor(&per_cu, (const void*)mk_fwd, NTHREADS, LDS_BYTES) != hipSuccess || per_cu < 1) { fprintf(stderr, "kernel_launch: occupancy query says %d\n", per_cu); }
        (void)hipGetLastError();
        grid = cus;
    }
    if (grid < 0) return;
    if (hipMemsetAsync((char*)d_ws + WS_CTL, 0, CTL_ZERO_BYTES, stream) != hipSuccess) return;
    Args a{};
    for (int i = 0; i < 20; ++i) a.in[i] = (const float*)d_in[i];
    a.out = (float*)d_out; a.ws = (unsigned char*)d_ws;
#if MK_ONE_LAUNCH
    a.ph_lo = 0; a.ph_hi = NPH;
    hipLaunchKernelGGL(mk_fwd, dim3(grid), dim3(NTHREADS), LDS_BYTES, stream, a);
#else
    for (int p = 0; p < NPH; ++p) { a.ph_lo = p; a.ph_hi = p + 1; hipLaunchKernelGGL(mk_fwd, dim3(grid), dim3(NTHREADS), LDS_BYTES, stream, a); }
#endif
}
```
